# Optimizing an MI355X kernel written in HIP

```python
import jax
import jax.numpy as jnp
from jax import lax
import numpy as np


D_MODEL = 1024
BATCH = 16
SEQ = 4096
DEPTH = 4

CHUNK = 64
N_META = 16
N_HEADS_A = 8
HEAD_DIM = 64
D_A = N_HEADS_A * HEAD_DIM
N_IDX_HEADS = 8
IDX_DIM = HEAD_DIM
TOPK_MAX = 256
POOL_WINDOWS = (2, 4, 8, 16)
N_POOL_GROUPS = len(POOL_WINDOWS)
D_B = D_MODEL // 2
POOL_GROUP_DIM = D_B // N_POOL_GROUPS
Q_BLOCK = 128
ROPE_THETA = 10000.0
EPS = 1e-6
NEG_INF = -1e30
IN_WIDTHS = (D_A, HEAD_DIM, HEAD_DIM, D_A, D_B, D_B, N_IDX_HEADS * IDX_DIM, IDX_DIM, N_IDX_HEADS, 2 * D_MODEL)
D_IN = sum(IN_WIDTHS)

kernel_name = 'hybrid_dsa_pool_gated_block'


def rms_norm(x, g):
    xf = x.astype(jnp.float32)
    y = xf * lax.rsqrt(jnp.mean(xf * xf, axis=-1, keepdims=True) + EPS)
    return (y * g.astype(jnp.float32)).astype(x.dtype)


def rope_tables(length, dim):
    inv_freq = 1.0 / (ROPE_THETA ** (jnp.arange(0, dim, 2, dtype=jnp.float32) / dim))
    ang = jnp.arange(length, dtype=jnp.float32)[:, None] * inv_freq[None, :]
    ang = jnp.concatenate([ang, ang], axis=-1)
    return jnp.cos(ang), jnp.sin(ang)


def apply_rope(x, cos, sin):
    half = x.shape[-1] // 2
    xf = x.astype(jnp.float32)
    rot = jnp.concatenate([-xf[..., half:], xf[..., :half]], axis=-1)
    return (xf * cos + rot * sin).astype(x.dtype)


def chunk_id(pos):
    return jnp.where(pos < N_META, 0, 1 + (pos - N_META) // CHUNK)


def indexer_sparse_attention(q, k, v, q_idx, k_idx, w_idx, k_top):
    B, T = q.shape[0], q.shape[1]
    n_blk = -(-T // Q_BLOCK)
    t_pad = n_blk * Q_BLOCK

    def to_blocks(a):
        a = jnp.pad(a, [(0, 0), (0, t_pad - T)] + [(0, 0)] * (a.ndim - 2))
        return jnp.moveaxis(a.reshape((B, n_blk, Q_BLOCK) + a.shape[2:]), 1, 0)

    key_chunk = chunk_id(jnp.arange(T))
    query_chunk = chunk_id(jnp.arange(t_pad)).reshape(n_blk, Q_BLOCK)
    k_idx_f = k_idx.astype(jnp.float32)
    idx_scale = (N_IDX_HEADS ** -0.5) * (IDX_DIM ** -0.5)
    attn_scale = HEAD_DIM ** -0.5
    gather = jax.vmap(lambda table, ids: table[ids])

    def one_block(args):
        qb, qib, wib, qcb = args
        s = jnp.einsum('bqhd,bkd->bqhk', qib.astype(jnp.float32), k_idx_f)
        score = jnp.einsum('bqhk,bqh->bqk', jax.nn.relu(s), wib.astype(jnp.float32) * idx_scale)
        visible = key_chunk[None, :] <= qcb[:, None]
        score = jnp.where(visible[None], score, NEG_INF)
        _, sel = lax.top_k(score, k_top)
        valid = key_chunk[sel] <= qcb[None, :, None]
        kg = gather(k, sel)
        vg = gather(v, sel)
        logits = jnp.einsum('bqhd,bqkd->bqhk', qb, kg).astype(jnp.float32) * attn_scale
        logits = jnp.where(valid[:, :, None, :], logits, NEG_INF)
        p = jax.nn.softmax(logits, axis=-1).astype(vg.dtype)
        return jnp.einsum('bqhk,bqkd->bqhd', p, vg)

    out = lax.map(one_block, (to_blocks(q), to_blocks(q_idx), to_blocks(w_idx), query_chunk))
    return jnp.moveaxis(out, 0, 1).reshape(B, t_pad, N_HEADS_A, HEAD_DIM)[:, :T]


def multiscale_pool(u, pool_w, pool_b, pool_s):
    B, T, C = u.shape
    G = POOL_GROUP_DIM
    uf = u.astype(jnp.float32)
    cs = jnp.concatenate([jnp.zeros((B, 1, C), jnp.float32), jnp.cumsum(uf, axis=1)], axis=1)
    t1 = jnp.arange(1, T + 1, dtype=jnp.float32)
    means = []
    for g, w in enumerate(POOL_WINDOWS):
        csg = cs[..., g * G:(g + 1) * G]
        lag = jnp.concatenate([jnp.zeros((B, w, G), jnp.float32), csg[:, :T + 1 - w]], axis=1)
        cnt = jnp.minimum(t1, float(w))
        means.append((csg[:, 1:] - lag[:, 1:]) / cnt[None, :, None])
    pooled = (jnp.concatenate(means, axis=-1) - uf).astype(u.dtype).reshape(B, T, N_POOL_GROUPS, G)
    mixed = jnp.einsum('btgc,gcd->btgd', pooled, pool_w) + pool_b.reshape(N_POOL_GROUPS, G)
    return mixed.reshape(B, T, C) * pool_s


def hybrid_layer(x, norm_g, w_in, qn_g, kn_g, pool_w, pool_b, pool_s, w_a, w_b, w_out, cos, sin, k_top):
    B, T, _ = x.shape
    h = rms_norm(x, norm_g)
    proj = jnp.einsum('btd,de->bte', h, w_in)
    q, k, v, gate_a, u_b, gate_b, q_idx, k_idx, w_idx, merge = jnp.split(
        proj, np.cumsum(IN_WIDTHS)[:-1].tolist(), axis=-1)
    cos_h, sin_h = cos[:, None, :], sin[:, None, :]
    q = apply_rope(rms_norm(q.reshape(B, T, N_HEADS_A, HEAD_DIM), qn_g), cos_h, sin_h)
    k = apply_rope(rms_norm(k, kn_g), cos, sin)
    q_idx = apply_rope(q_idx.reshape(B, T, N_IDX_HEADS, IDX_DIM), cos_h, sin_h)
    k_idx = apply_rope(k_idx, cos, sin)
    attn = indexer_sparse_attention(q, k, v, q_idx, k_idx, w_idx, k_top).reshape(B, T, D_A)
    y_a = jnp.einsum('bte,ed->btd', attn * jax.nn.silu(gate_a), w_a)
    pooled = multiscale_pool(u_b, pool_w, pool_b, pool_s)
    y_b = jnp.einsum('bte,ed->btd', pooled * jax.nn.silu(gate_b), w_b)
    g_a, g_b = jnp.split(jax.nn.sigmoid(merge), 2, axis=-1)
    return x + jnp.einsum('btd,de->bte', g_a * y_a + g_b * y_b, w_out)


def setup_inputs(seed: int = 0) -> dict:
    key = jax.random.key(seed)
    ks = jax.random.split(key, 12)

    def nrm(k, shape, scale):
        return scale * jax.random.normal(k, shape, jnp.float32)

    return {
        'x': nrm(ks[0], (BATCH, SEQ, D_MODEL), 1.0),
        'meta_tokens': nrm(ks[1], (N_META, D_MODEL), 1.0),
        'norm_gain': 1.0 + nrm(ks[2], (DEPTH, D_MODEL), 0.05),
        'w_in': nrm(ks[3], (DEPTH, D_MODEL, D_IN), D_MODEL ** -0.5),
        'q_norm_gain': 1.0 + nrm(ks[4], (DEPTH, HEAD_DIM), 0.05),
        'k_norm_gain': 1.0 + nrm(ks[5], (DEPTH, HEAD_DIM), 0.05),
        'pool_w': nrm(ks[6], (DEPTH, N_POOL_GROUPS, POOL_GROUP_DIM, POOL_GROUP_DIM), POOL_GROUP_DIM ** -0.5),
        'pool_b': nrm(ks[7], (DEPTH, D_B), 0.02),
        'pool_scale': 1.0 + nrm(ks[8], (DEPTH, D_B), 0.1),
        'w_branch_a': nrm(ks[9], (DEPTH, D_A, D_MODEL), D_A ** -0.5),
        'w_branch_b': nrm(ks[10], (DEPTH, D_B, D_MODEL), D_B ** -0.5),
        'w_out': nrm(ks[11], (DEPTH, D_MODEL, D_MODEL), D_MODEL ** -0.5),
    }


def reference(x, meta_tokens, norm_gain, w_in, q_norm_gain, k_norm_gain, pool_w, pool_b, pool_scale,
              w_branch_a, w_branch_b, w_out):
    B, S, _ = x.shape
    k_top = min(TOPK_MAX, S // 4)
    meta = jnp.broadcast_to(meta_tokens.astype(x.dtype)[None], (B, N_META, D_MODEL))
    h = jnp.concatenate([meta, x], axis=1)
    T = S + N_META
    cos, sin = rope_tables(T, HEAD_DIM)
    for l in range(DEPTH):
        h = hybrid_layer(h, norm_gain[l], w_in[l], q_norm_gain[l], k_norm_gain[l], pool_w[l], pool_b[l],
                         pool_scale[l], w_branch_a[l], w_branch_b[l], w_out[l], cos, sin, k_top)
    return h[:, N_META:]
```

```cpp
#include <hip/hip_runtime.h>
#include <hip/hip_cooperative_groups.h>
#include <cstdio>
#include <cstdint>
namespace cg = cooperative_groups;

#ifndef PROBE_DOUBLE
#define PROBE_DOUBLE 0
#endif
#ifndef PER_PHASE_LAUNCH
#define PER_PHASE_LAUNCH 0
#endif

#define LAS __attribute__((address_space(3)))
#define GAS __attribute__((address_space(1)))
typedef _Float16 h16;
typedef _Float16 h16x8 __attribute__((ext_vector_type(8)));
typedef _Float16 h16x4 __attribute__((ext_vector_type(4)));
typedef _Float16 h16x2 __attribute__((ext_vector_type(2)));
typedef __fp16 fp16x4 __attribute__((__vector_size__(4 * sizeof(__fp16))));
typedef float f32x2 __attribute__((ext_vector_type(2)));
typedef float f32x4 __attribute__((ext_vector_type(4)));
typedef float f32x16 __attribute__((ext_vector_type(16)));
typedef unsigned u32x4 __attribute__((ext_vector_type(4)));
typedef unsigned u32x2 __attribute__((ext_vector_type(2)));

constexpr int NB = 16, SEQ = 4096, NMETA = 16, T = 4112, DM = 1024, DEPTH = 4, R = NB * T;
constexpr int DIN = 4808, NP = 4864;
constexpr int C_Q = 0, C_GA = 512, C_UB = 1024, C_GB = 1536, C_QI = 2048, C_MG = 2560, C_K = 4608, C_V = 4672, C_KI = 4736, C_WI = 4800;
constexpr float EPS = 1e-6f;

constexpr size_t WS_WIN = 0;
constexpr size_t WS_WA = WS_WIN + (size_t)DEPTH * NP * DM * 2;
constexpr size_t WS_WB = WS_WA + (size_t)DEPTH * DM * 512 * 2;
constexpr size_t WS_WO = WS_WB + (size_t)DEPTH * DM * 512 * 2;
constexpr size_t WS_WP = WS_WO + (size_t)DEPTH * DM * DM * 2;
constexpr size_t WS_ROPE = WS_WP + (size_t)DEPTH * 4 * 128 * 128 * 2;
constexpr size_t WS_META = WS_ROPE + (size_t)T * 32 * 8;
constexpr size_t WS_H = WS_META + (size_t)NB * NMETA * DM * 4;
constexpr size_t WS_PROJ = WS_H + (size_t)R * DM * 2;
constexpr size_t WS_AA = WS_PROJ + (size_t)R * NP * 2 + 65536;
constexpr size_t WS_BB = WS_AA + (size_t)R * 512 * 2;
constexpr size_t WS_KC = WS_BB + (size_t)R * 512 * 2;
constexpr size_t WS_VC = WS_KC + (size_t)(R + 64) * 128;
constexpr size_t WS_KIC = WS_VC + (size_t)(R + 64) * 128;
constexpr size_t WS_BAR = WS_KIC + (size_t)(R + 64) * 128;
constexpr size_t WS_END = WS_BAR + 32768;

constexpr int SCW = 4128;
constexpr int L_SC = 0;
constexpr int L_HQ = 8 * SCW * 4;
constexpr int L_SEL = L_HQ + 16384;
constexpr int L_MM = L_SEL + 4096;
constexpr int L_BARST = L_SEL + 4096 + 512;
constexpr int L_QA = L_SEL + 4096 + 1024;
constexpr int LDS_BYTES = L_QA + 8192;

struct Args {
    const float* x; const float* meta; const float* norm_g; const float* w_in; const float* qn_g; const float* kn_g;
    const float* pool_w; const float* pool_b; const float* pool_s; const float* w_a; const float* w_b; const float* w_out;
    float* out; unsigned char* ws; int ph_lo, ph_hi;
};

typedef __attribute__((address_space(4))) const unsigned char* kargp_t;
__device__ __forceinline__ Args opaque_args() {
#if defined(__HIP_DEVICE_COMPILE__)
    kargp_t kp = (kargp_t)__builtin_amdgcn_kernarg_segment_ptr();
    unsigned off; asm volatile("s_mov_b32 %0, 0" : "=s"(off));
    const __attribute__((address_space(4))) unsigned long long* p = (const __attribute__((address_space(4))) unsigned long long*)(kp + off);
    Args a;
    a.x = (const float*)(const GAS float*)p[0]; a.meta = (const float*)(const GAS float*)p[1]; a.norm_g = (const float*)(const GAS float*)p[2]; a.w_in = (const float*)(const GAS float*)p[3];
    a.qn_g = (const float*)(const GAS float*)p[4]; a.kn_g = (const float*)(const GAS float*)p[5]; a.pool_w = (const float*)(const GAS float*)p[6]; a.pool_b = (const float*)(const GAS float*)p[7];
    a.pool_s = (const float*)(const GAS float*)p[8]; a.w_a = (const float*)(const GAS float*)p[9]; a.w_b = (const float*)(const GAS float*)p[10]; a.w_out = (const float*)(const GAS float*)p[11];
    a.out = (float*)(GAS float*)p[12]; a.ws = (unsigned char*)(GAS unsigned char*)p[13]; a.ph_lo = 0; a.ph_hi = 0;
    return a;
#else
    return Args{};
#endif
}
__device__ __forceinline__ int olane() { int l = (int)__builtin_amdgcn_mbcnt_hi(~0u, __builtin_amdgcn_mbcnt_lo(~0u, 0u)); asm volatile("" : "+v"(l)); return l; }
__device__ __forceinline__ int otid(int wave_s) { return wave_s * 64 + olane(); }
__device__ __forceinline__ int obid() { int b = (int)blockIdx.x; asm volatile("" : "+s"(b)); return b; }
__device__ __forceinline__ unsigned pk2h(float a, float b) { h16x2 v; v.x = (h16)a; v.y = (h16)b; return __builtin_bit_cast(unsigned, v); }
__device__ __forceinline__ float wave_sum(float v) {
#pragma unroll
    for (int o = 1; o < 64; o <<= 1) v += __shfl_xor(v, o);
    return v;
}
__device__ __forceinline__ float fsigmoid(float x) { return __builtin_amdgcn_rcpf(1.0f + __expf(-x)); }
#define LDS_FENCE() asm volatile("s_waitcnt lgkmcnt(0)" ::: "memory")
#define LDS_ORDER() asm volatile("" ::: "memory")

namespace pg8 {
constexpr int BM = 256, BK = 64, HALF = 128, HTB = HALF * BK * 2, STAGE_BYTES = 8 * HTB, NXCD = 8, WGM = 8;
__device__ __forceinline__ int lds_byte(int r, int c) { const int st = (r >> 4) * 2 + (c >> 5), rr = r & 15, cc = c & 31, ob = rr * 64 + cc * 2; return st * 1024 + (ob ^ (((ob >> 9) & 1) << 5)); }
__device__ __forceinline__ void stage_rc(int b, int& Rr, int& C) { const int st = b / 1024, sb = b % 1024, swz = sb ^ (((sb >> 9) & 1) << 5); Rr = (st >> 1) * 16 + swz / 64; C = (st & 1) * 32 + (swz % 64) / 2; }
__device__ __forceinline__ int perm32(int rho) { const int n = rho >> 4, i = rho & 15; return 8 * (i >> 2) + 4 * n + (i & 3); }
struct Unit { int pm, pn; };
struct Gemm { const h16* A; const h16* Bt; int M, N, K; const h16* A2; const h16* Bt2; };
struct StaticOrder {
    int nM, nN, nwg, G, c;
    __device__ void init(int M, int N, int G_, int c_) { nM = M / BM; nN = N / BM; nwg = nM * nN; G = G_; c = c_; }
    __device__ bool next(int i, Unit& u) const {
        const long L = (long)i * G + c; if (L >= nwg) return false;
        int wgid = (int)L; { const int q = nwg / NXCD, r = nwg % NXCD, xcd = wgid % NXCD, off = wgid / NXCD; wgid = (xcd < r ? xcd * (q + 1) : r * (q + 1) + (xcd - r) * q) + off; }
        const int nig = WGM * nN, gid = wgid / nig, fm = gid * WGM, gsz = (nM - fm) < WGM ? (nM - fm) : WGM;
        u.pm = fm + ((wgid % nig) % gsz); u.pn = (wgid % nig) / gsz; return true;
    }
};

template <class Epi, class Sched, bool DUAL = false>
__device__ __forceinline__ void gemm_phase(LAS unsigned char* lds, const Gemm g, const Sched& S, const Epi& E, int wave_s) {
    const int tid = otid(wave_s), wid = __builtin_amdgcn_readfirstlane(tid >> 6), lane = tid & 63, wr = wid >> 2, wc = wid & 3, fr = lane & 15, fq = lane >> 4;
    const int K = g.K, nt = K / BK;
    unsigned voffA[2], voffB0[2], voffB1[2];
#pragma unroll
    for (int i = 0; i < 2; ++i) { int Rr, C; stage_rc(tid * 16 + i * 8192, Rr, C); const int pr = Epi::PERM ? perm32(Rr & 31) : (Rr & 31); const int Rb = (Rr >> 5) * 64 + pr;
        voffA[i] = (unsigned)(Rr * K + C) * 2u; voffB0[i] = (unsigned)(Rb * K + C) * 2u; voffB1[i] = (unsigned)((Rb + 32) * K + C) * 2u; }
    const size_t kstep = (size_t)(BK * 2);
    const size_t hstep = (size_t)HALF * K * 2;
    const size_t tstep = 2 * hstep;
    const unsigned ldsw = (unsigned)wid * 1024u;
    const int aoff = lds_byte(wr * 64 + fr, fq * 8), boff = lds_byte(wc * 32 + fr, fq * 8);
#define PG8_SA(b, h) (((b) * 2 + (h)) * HTB)
#define PG8_SB(b, h) ((4 + (b) * 2 + (h)) * HTB)
#define PG8_STAGE(bufoff, gbase, voff) do { _Pragma("unroll") for (int _i = 0; _i < 2; ++_i) \
        __builtin_amdgcn_global_load_lds((const unsigned*)((const char*)(gbase) + (voff)[_i]), (LAS unsigned*)(lds + (bufoff) + ldsw + _i * 8192), 16, 0, 0); } while (0)
#define PG8_LDA(dst, b, h) do { _Pragma("unroll") for (int m = 0; m < 4; ++m) _Pragma("unroll") for (int k = 0; k < 2; ++k) dst[m][k] = *(const LAS h16x8*)(lds + PG8_SA(b, h) + aoff + m * 2048 + k * 1024); } while (0)
#define PG8_LDB(dst, b, h) do { _Pragma("unroll") for (int n = 0; n < 2; ++n) _Pragma("unroll") for (int k = 0; k < 2; ++k) dst[n][k] = *(const LAS h16x8*)(lds + PG8_SB(b, h) + boff + n * 2048 + k * 1024); } while (0)
#define PG8_MMA(ai, bj, At, Bt) do { __builtin_amdgcn_s_setprio(1); _Pragma("unroll") for (int m = 0; m < 4; ++m) _Pragma("unroll") for (int n = 0; n < 2; ++n) _Pragma("unroll") for (int k = 0; k < 2; ++k) \
        acc[ai][bj][m][n] = __builtin_amdgcn_mfma_f32_16x16x32_f16(Bt[n][k], At[m][k], acc[ai][bj][m][n], 0, 0, 0); __builtin_amdgcn_s_setprio(0); } while (0)
#define PG8_WAIT_V(n) asm volatile("s_waitcnt vmcnt(" #n ")" ::: "memory")
#define PG8_WAIT_L(n) asm volatile("s_waitcnt lgkmcnt(" #n ")" ::: "memory")
#define PG8_BAR __builtin_amdgcn_s_barrier()
#define PG8_SCHED __builtin_amdgcn_sched_barrier(0)
    Unit cur, nxt; int ui = 0;
    if (!S.next(0, cur)) return;
    f32x4 acc[2][2][4][2];
#pragma unroll
    for (int a = 0; a < 2; ++a)
#pragma unroll
        for (int b = 0; b < 2; ++b)
#pragma unroll
            for (int m = 0; m < 4; ++m)
#pragma unroll
                for (int n = 0; n < 2; ++n) acc[a][b][m][n] = (f32x4){0.f, 0.f, 0.f, 0.f};
    h16x8 At[4][2], B0[2][2], B1[2][2];
    const char* cA = (const char*)g.A + (size_t)cur.pm * tstep; const char* cB = (const char*)g.Bt + (size_t)cur.pn * tstep;
    PG8_STAGE(PG8_SB(0, 0), cB, voffB0); PG8_STAGE(PG8_SA(0, 0), cA, voffA); PG8_STAGE(PG8_SB(0, 1), cB, voffB1); PG8_STAGE(PG8_SA(0, 1), cA + hstep, voffA);
    if (wr == 1) PG8_BAR;
    PG8_WAIT_V(4); PG8_BAR;
    PG8_STAGE(PG8_SB(1, 0), cB + kstep, voffB0); PG8_STAGE(PG8_SA(1, 0), cA + kstep, voffA); PG8_STAGE(PG8_SB(1, 1), cB + kstep, voffB1);
    PG8_WAIT_V(6); PG8_BAR;
#define PG8_KLOOP(cA_, cB_, nA_, nB_) do { \
        for (int t = 0; t < nt; t += 2) { \
            const bool last = (t == nt - 2); \
            const char* a1 = (cA_) + (size_t)(t + 1) * kstep; \
            const char* a2 = last ? (nA_) : (cA_) + (size_t)(t + 2) * kstep; const char* b2 = last ? (nB_) : (cB_) + (size_t)(t + 2) * kstep; \
            const char* a3 = a2 + kstep; const char* b3 = b2 + kstep; \
            PG8_LDB(B0, 0, 0); PG8_SCHED; PG8_LDA(At, 0, 0); PG8_STAGE(PG8_SA(1, 1), a1 + hstep, voffA); \
            PG8_WAIT_L(8); PG8_BAR; PG8_WAIT_L(0); PG8_MMA(0, 0, At, B0); PG8_BAR; PG8_SCHED; \
            PG8_LDB(B1, 0, 1); PG8_STAGE(PG8_SB(0, 0), b2, voffB0); \
            PG8_BAR; PG8_WAIT_L(0); PG8_MMA(0, 1, At, B1); PG8_BAR; \
            PG8_LDA(At, 0, 1); PG8_STAGE(PG8_SA(0, 0), a2, voffA); \
            PG8_BAR; PG8_WAIT_L(0); PG8_MMA(1, 0, At, B0); PG8_BAR; PG8_SCHED; \
            PG8_STAGE(PG8_SB(0, 1), b2, voffB1); \
            PG8_WAIT_V(6); PG8_BAR; PG8_MMA(1, 1, At, B1); PG8_BAR; \
            PG8_LDB(B0, 1, 0); PG8_SCHED; PG8_LDA(At, 1, 0); PG8_STAGE(PG8_SA(0, 1), a2 + hstep, voffA); \
            PG8_WAIT_L(8); PG8_BAR; PG8_WAIT_L(0); PG8_MMA(0, 0, At, B0); PG8_BAR; PG8_SCHED; \
            PG8_LDB(B1, 1, 1); PG8_STAGE(PG8_SB(1, 0), b3, voffB0); \
            PG8_BAR; PG8_WAIT_L(0); PG8_MMA(0, 1, At, B1); PG8_BAR; \
            PG8_LDA(At, 1, 1); PG8_STAGE(PG8_SA(1, 0), a3, voffA); \
            PG8_BAR; PG8_WAIT_L(0); PG8_MMA(1, 0, At, B0); PG8_BAR; PG8_SCHED; \
            PG8_STAGE(PG8_SB(1, 1), b3, voffB1); \
            PG8_WAIT_V(6); PG8_BAR; PG8_MMA(1, 1, At, B1); PG8_BAR; \
        } \
    } while (0)
    for (;;) {
        if constexpr (DUAL) {
            const char* mA = (const char*)g.A2 + (size_t)cur.pm * tstep; const char* mB = (const char*)g.Bt2 + (size_t)cur.pn * tstep;
            PG8_KLOOP(cA, cB, mA, mB);
            E.mid(acc, cur, wr, wc, fr, fq, lds + 131072 + wid * 2048);
            cA = mA; cB = mB;
        }
        const bool has_next = S.next(ui + 1, nxt);
        const char* nA = has_next ? (const char*)g.A + (size_t)nxt.pm * tstep : cA; const char* nB = has_next ? (const char*)g.Bt + (size_t)nxt.pn * tstep : cB;
        PG8_KLOOP(cA, cB, nA, nB);
        E(acc, cur, wr, wc, fr, fq, lds + 131072 + wid * 2048);
        if (!has_next) break;
#pragma unroll
        for (int a = 0; a < 2; ++a)
#pragma unroll
            for (int b = 0; b < 2; ++b)
#pragma unroll
                for (int m = 0; m < 4; ++m)
#pragma unroll
                    for (int n = 0; n < 2; ++n) acc[a][b][m][n] = (f32x4){0.f, 0.f, 0.f, 0.f};
        cur = nxt; cA = nA; cB = nB; ++ui;
    }
    PG8_WAIT_V(0);
    if (wr == 0) PG8_BAR;
    PG8_BAR;
#undef PG8_KLOOP
#undef PG8_SA
#undef PG8_SB
#undef PG8_STAGE
#undef PG8_LDA
#undef PG8_LDB
#undef PG8_MMA
#undef PG8_WAIT_V
#undef PG8_WAIT_L
#undef PG8_BAR
#undef PG8_SCHED
}
}

__device__ __forceinline__ const float* xrow_src(const Args& a, int l, int row) {
    const int b = row / T, t = row - b * T;
    if (l == 0) return t < NMETA ? a.meta + (size_t)t * DM : a.x + ((size_t)b * SEQ + (t - NMETA)) * DM;
    return t < NMETA ? (const float*)(a.ws + WS_META) + ((size_t)b * NMETA + t) * DM : a.out + ((size_t)b * SEQ + (t - NMETA)) * DM;
}
__device__ __forceinline__ float* xrow_dst(const Args& a, int row) {
    const int b = row / T, t = row - b * T;
    return t < NMETA ? (float*)(a.ws + WS_META) + ((size_t)b * NMETA + t) * DM : a.out + ((size_t)b * SEQ + (t - NMETA)) * DM;
}

__device__ __forceinline__ int xoff(int row, int piece) { return row * 128 + ((piece ^ (row & 7)) * 16); }
struct EpiProj {
    static constexpr bool PERM = true;
    h16* O;
    __device__ __forceinline__ void operator()(const f32x4 (&acc)[2][2][4][2], const pg8::Unit& u, int wr, int wc, int fr, int fq, LAS unsigned char* xl) const {
        int row0 = u.pm * 256 + wr * 64, col0 = u.pn * 256 + wc * 64;
        asm volatile("" : "+s"(row0), "+s"(col0));
        const int ln = fq * 16 + fr, rr = ln >> 3, pp = ln & 7;
        const int pn = u.pn;
        const int act = (pn == 2 || pn == 3 || pn == 6 || pn == 7) ? 1 : ((pn >= 10 && pn < 18) ? 2 : 0);
#pragma unroll
        for (int ai = 0; ai < 2; ++ai)
#pragma unroll
            for (int m = 0; m < 4; ++m) {
#pragma unroll
                for (int bj = 0; bj < 2; ++bj) { f32x4 v0 = acc[ai][bj][m][0], v1 = acc[ai][bj][m][1];
                    if (act) {
#pragma unroll
                        for (int e = 0; e < 4; ++e) { const float s0 = fsigmoid(v0[e]), s1 = fsigmoid(v1[e]); v0[e] = act == 1 ? v0[e] * s0 : s0; v1[e] = act == 1 ? v1[e] * s1 : s1; }
                    }
                    u32x4 o; o.x = pk2h(v0[0], v0[1]); o.y = pk2h(v0[2], v0[3]); o.z = pk2h(v1[0], v1[1]); o.w = pk2h(v1[2], v1[3]);
                    *(LAS u32x4*)(xl + xoff(fr, bj * 4 + fq)) = o; }
                LDS_FENCE();
                const u32x4 t0 = *(const LAS u32x4*)(xl + xoff(rr, pp)), t1 = *(const LAS u32x4*)(xl + xoff(rr + 8, pp));
                h16* rowp = O + (size_t)(row0 + ai * 128 + m * 16 + rr) * NP + col0 + pp * 8;
                *(u32x4*)rowp = t0; *(u32x4*)(rowp + (size_t)8 * NP) = t1;
                LDS_ORDER();
            }
    }
};
__device__ __forceinline__ float gsig(float mb) { return fmaxf(fsigmoid(mb), 6.1035e-5f); }
struct EpiMerge2 {
    static constexpr bool PERM = true;
    h16* O; const h16* G;
    __device__ __forceinline__ void mid(f32x4 (&acc)[2][2][4][2], const pg8::Unit& u, int wr, int wc, int fr, int fq, LAS unsigned char* xl) const {
        int row0 = u.pm * 256 + wr * 64, col0 = u.pn * 256 + wc * 64;
        asm volatile("" : "+s"(row0), "+s"(col0));
        const int ln = fq * 16 + fr, rr = ln >> 3, pp = ln & 7;
#pragma unroll
        for (int aim = 0; aim < 4; ++aim) { const int ai = aim >> 1, mb = (aim & 1) * 2;
            h16x8 ga[4][2], gb[4][2];
#pragma unroll
            for (int m = mb; m < mb + 2; ++m) { const h16* gp = G + (size_t)(row0 + ai * 128 + m * 16 + rr) * NP + col0 + pp * 8;
                ga[m][0] = *(const h16x8*)gp; gb[m][0] = *(const h16x8*)(gp + 1024); ga[m][1] = *(const h16x8*)(gp + (size_t)8 * NP); gb[m][1] = *(const h16x8*)(gp + (size_t)8 * NP + 1024); }
            __builtin_amdgcn_sched_barrier(0);
#pragma unroll
            for (int m = mb; m < mb + 2; ++m) {
                h16x8 r0, r1;
#pragma unroll
                for (int e = 0; e < 8; ++e) { r0[e] = (h16)((float)ga[m][0][e] * __builtin_amdgcn_rcpf(fmaxf((float)gb[m][0][e], 6.1035e-5f))); r1[e] = (h16)((float)ga[m][1][e] * __builtin_amdgcn_rcpf(fmaxf((float)gb[m][1][e], 6.1035e-5f))); }
                *(LAS h16x8*)(xl + xoff(rr, pp)) = r0; *(LAS h16x8*)(xl + xoff(rr + 8, pp)) = r1;
                LDS_FENCE();
#pragma unroll
                for (int bj = 0; bj < 2; ++bj) { const h16x8 rt = *(const LAS h16x8*)(xl + xoff(fr, bj * 4 + fq));
#pragma unroll
                    for (int e = 0; e < 4; ++e) { const float f0 = (float)rt[e], f1 = (float)rt[4 + e];
                        asm volatile("v_mul_f32 %0, %0, %1" : "+v"(acc[ai][bj][m][0][e]) : "v"(f0)); asm volatile("v_mul_f32 %0, %0, %1" : "+v"(acc[ai][bj][m][1][e]) : "v"(f1)); } }
                LDS_ORDER();
            }
        }
    }
    __device__ __forceinline__ void operator()(const f32x4 (&acc)[2][2][4][2], const pg8::Unit& u, int wr, int wc, int fr, int fq, LAS unsigned char* xl) const {
        int row0 = u.pm * 256 + wr * 64, col0 = u.pn * 256 + wc * 64;
        asm volatile("" : "+s"(row0), "+s"(col0));
        const int ln = fq * 16 + fr, rr = ln >> 3, pp = ln & 7;
#pragma unroll
        for (int ai = 0; ai < 2; ++ai) {
            h16x8 gb[2][4][2];
#pragma unroll
            for (int m = 0; m < 4; ++m) { const h16* gp = G + (size_t)(row0 + ai * 128 + m * 16 + rr) * NP + col0 + pp * 8 + 1024;
                gb[ai][m][0] = *(const h16x8*)gp; gb[ai][m][1] = *(const h16x8*)(gp + (size_t)8 * NP); }
            __builtin_amdgcn_sched_barrier(0);
#pragma unroll
            for (int m = 0; m < 4; ++m) {
#pragma unroll
                for (int bj = 0; bj < 2; ++bj) { const f32x4 v0 = acc[ai][bj][m][0], v1 = acc[ai][bj][m][1];
                    u32x4 o; o.x = pk2h(v0[0], v0[1]); o.y = pk2h(v0[2], v0[3]); o.z = pk2h(v1[0], v1[1]); o.w = pk2h(v1[2], v1[3]);
                    *(LAS u32x4*)(xl + xoff(fr, bj * 4 + fq)) = o; }
                LDS_FENCE();
                const h16x8 t0 = *(const LAS h16x8*)(xl + xoff(rr, pp)), t1 = *(const LAS h16x8*)(xl + xoff(rr + 8, pp));
                float q0[8], q1[8];
#pragma unroll
                for (int e = 0; e < 8; ++e) { q0[e] = (float)t0[e] * fmaxf((float)gb[ai][m][0][e], 6.1035e-5f); q1[e] = (float)t1[e] * fmaxf((float)gb[ai][m][1][e], 6.1035e-5f); }
                u32x4 o0, o1; o0.x = pk2h(q0[0], q0[1]); o0.y = pk2h(q0[2], q0[3]); o0.z = pk2h(q0[4], q0[5]); o0.w = pk2h(q0[6], q0[7]);
                o1.x = pk2h(q1[0], q1[1]); o1.y = pk2h(q1[2], q1[3]); o1.z = pk2h(q1[4], q1[5]); o1.w = pk2h(q1[6], q1[7]);
                h16* rowp = O + (size_t)(row0 + ai * 128 + m * 16 + rr) * DM + col0 + pp * 8;
                *(u32x4*)rowp = o0; *(u32x4*)(rowp + (size_t)8 * DM) = o1;
                LDS_ORDER();
            }
        }
    }
};
struct EpiResid {
    static constexpr bool PERM = false;
    const float* s_real; const float* s_meta; int s_meta_bstride; float* d_real; float* d_meta;
    __device__ __forceinline__ void operator()(const f32x4 (&acc)[2][2][4][2], const pg8::Unit& u, int wr, int wc, int fr, int fq, LAS unsigned char* xl) const {
        int row0 = u.pm * 256 + wr * 64, col0 = u.pn * 256 + wc * 64;
        asm volatile("" : "+s"(row0), "+s"(col0));
        const int ln = fq * 16 + fr, rr = ln >> 3, pp = ln & 7;
#pragma unroll
        for (int aim = 0; aim < 4; ++aim) { const int ai = aim >> 1, mb = (aim & 1) * 2;
            f32x4 xo[4][2][2];
#pragma unroll
            for (int m = mb; m < mb + 2; ++m)
#pragma unroll
                for (int h = 0; h < 2; ++h) { const int row = row0 + ai * 128 + m * 16 + rr + 8 * h; const int b = row / T, t = row - b * T;
                    const float* sp = (t < NMETA ? s_meta + (size_t)b * s_meta_bstride + (size_t)t * DM : s_real + ((size_t)b * SEQ + (t - NMETA)) * DM) + col0 + pp * 4;
                    xo[m][h][0] = *(const f32x4*)sp; xo[m][h][1] = *(const f32x4*)(sp + 32); }
            __builtin_amdgcn_sched_barrier(0);
#pragma unroll
            for (int m = mb; m < mb + 2; ++m) {
                float* dp[2];
#pragma unroll
                for (int h = 0; h < 2; ++h) { const int row = row0 + ai * 128 + m * 16 + rr + 8 * h; const int b = row / T, t = row - b * T;
                    dp[h] = (t < NMETA ? d_meta + ((size_t)b * NMETA + t) * DM : d_real + ((size_t)b * SEQ + (t - NMETA)) * DM) + col0 + pp * 4; }
#pragma unroll
                for (int bj = 0; bj < 2; ++bj) {
                    *(LAS f32x4*)(xl + xoff(fr, fq)) = acc[ai][bj][m][0]; *(LAS f32x4*)(xl + xoff(fr, 4 + fq)) = acc[ai][bj][m][1];
                    LDS_FENCE();
                    const f32x4 t0 = *(const LAS f32x4*)(xl + xoff(rr, pp)), t1 = *(const LAS f32x4*)(xl + xoff(rr + 8, pp));
                    *(f32x4*)(dp[0] + bj * 32) = xo[m][0][bj] + t0; *(f32x4*)(dp[1] + bj * 32) = xo[m][1][bj] + t1;
                    LDS_ORDER();
                }
            }
        }
    }
};

constexpr int RM = R - 256;
template <int MODE>
__device__ __forceinline__ void gemm_tail(const Args& a, int l, int wave_s) {
    const int tid = otid(wave_s), bid = obid(), wave = tid >> 6, lane = tid & 63, fr = lane & 15, fq = lane >> 4;
    const int gw = wave * (int)gridDim.x + bid, NGW = (int)gridDim.x * 8;
    constexpr int N = MODE == 0 ? NP : DM, K = MODE == 1 ? 512 : DM, NSEG = MODE == 1 ? 2 : 1;
    const h16* PROJ = (const h16*)(a.ws + WS_PROJ);
    for (int task = gw; task < 8 * (N / 16); task += NGW) {
        const int row0 = RM + (task & 7) * 32, col0 = (task >> 3) * 16;
        f32x4 acc[2];
#pragma unroll
        for (int mt = 0; mt < 2; ++mt) acc[mt] = (f32x4){0.f, 0.f, 0.f, 0.f};
#pragma unroll
        for (int seg = 0; seg < NSEG; ++seg) {
            const h16* A = MODE == 1 ? (const h16*)(a.ws + (seg ? WS_BB : WS_AA)) : (const h16*)(a.ws + WS_H);
            const h16* Bt = MODE == 0 ? (const h16*)(a.ws + WS_WIN) + (size_t)l * NP * DM : MODE == 1 ? (const h16*)(a.ws + (seg ? WS_WB : WS_WA)) + (size_t)l * DM * 512 : (const h16*)(a.ws + WS_WO) + (size_t)l * DM * DM;
            const h16* ap = A + (size_t)(row0 + fr) * K + fq * 8;
            const h16* bp = Bt + (size_t)(col0 + fr) * K + fq * 8;
#pragma unroll 8
            for (int k = 0; k < K; k += 32) {
                const h16x8 bf = *(const h16x8*)(bp + k);
#pragma unroll
                for (int mt = 0; mt < 2; ++mt) { const h16x8 af = *(const h16x8*)(ap + (size_t)mt * 16 * K + k); acc[mt] = __builtin_amdgcn_mfma_f32_16x16x32_f16(bf, af, acc[mt], 0, 0, 0); }
            }
            if (MODE == 1 && seg == 0) {
#pragma unroll
                for (int mt = 0; mt < 2; ++mt) { const h16* gp = PROJ + (size_t)(row0 + 16 * mt + fr) * NP + C_MG + col0 + 4 * fq;
                    const h16x4 ga = *(const h16x4*)gp, gb = *(const h16x4*)(gp + 1024);
#pragma unroll
                    for (int j = 0; j < 4; ++j) acc[mt][j] *= (float)ga[j] * __builtin_amdgcn_rcpf(fmaxf((float)gb[j], 6.1035e-5f)); }
            }
        }
#pragma unroll
        for (int mt = 0; mt < 2; ++mt) { const int row = row0 + 16 * mt + fr, c = col0 + 4 * fq;
            if (MODE == 0) { const int pn = c >> 8; const int act = (pn == 2 || pn == 3 || pn == 6 || pn == 7) ? 1 : ((pn >= 10 && pn < 18) ? 2 : 0);
                float v[4];
#pragma unroll
                for (int j = 0; j < 4; ++j) { const float x = acc[mt][j], sg = fsigmoid(x); v[j] = act == 1 ? x * sg : (act == 2 ? sg : x); }
                u32x2 o; o.x = pk2h(v[0], v[1]); o.y = pk2h(v[2], v[3]);
                *(u32x2*)((h16*)(a.ws + WS_PROJ) + (size_t)row * NP + c) = o;
            } else if (MODE == 1) { const h16x4 gb = *(const h16x4*)(PROJ + (size_t)row * NP + C_MG + 1024 + c);
                u32x2 o; o.x = pk2h(acc[mt][0] * fmaxf((float)gb[0], 6.1035e-5f), acc[mt][1] * fmaxf((float)gb[1], 6.1035e-5f)); o.y = pk2h(acc[mt][2] * fmaxf((float)gb[2], 6.1035e-5f), acc[mt][3] * fmaxf((float)gb[3], 6.1035e-5f));
                *(u32x2*)((h16*)(a.ws + WS_H) + (size_t)row * DM + c) = o;
            } else { const f32x4 xo = *(const f32x4*)(xrow_src(a, l, row) + c); *(f32x4*)(xrow_dst(a, row) + c) = xo + acc[mt]; }
        }
    }
}

__device__ __forceinline__ void tr_item(const float* W, int ldw, int K, int k0, int srccol0, int nvalid, h16* WT, LAS float* scr, int lane) {
    {
        const int c4 = (lane & 7) * 4; f32x4 v[8];
#pragma unroll
        for (int j = 0; j < 8; ++j) { const int kk = (lane >> 3) + 8 * j; v[j] = (c4 < nvalid) ? *(const f32x4*)(W + (size_t)(k0 + kk) * ldw + srccol0 + c4) : (f32x4){0.f, 0.f, 0.f, 0.f}; }
#pragma unroll
        for (int j = 0; j < 8; ++j) { const int kk = (lane >> 3) + 8 * j;
#pragma unroll
            for (int e = 0; e < 4; ++e) scr[kk * 33 + c4 + e] = v[j][e]; }
    }
    LDS_FENCE();
    const int c8 = lane & 7;
#pragma unroll
    for (int j = 0; j < 4; ++j) { const int n = (lane >> 3) + 8 * j; const LAS float* s = scr + (8 * c8) * 33 + n;
        u32x4 o; o.x = pk2h(s[0 * 33], s[1 * 33]); o.y = pk2h(s[2 * 33], s[3 * 33]); o.z = pk2h(s[4 * 33], s[5 * 33]); o.w = pk2h(s[6 * 33], s[7 * 33]);
        *(u32x4*)(WT + (size_t)n * K + k0 + 8 * c8) = o; }
    LDS_FENCE();
}
__device__ __forceinline__ void win_srcmap(int n0, int& src, int& nvalid) {
    nvalid = 32;
    if (n0 < 512) src = n0;
    else if (n0 < 1024) src = 640 + (n0 - 512);
    else if (n0 < 1536) src = 1152 + (n0 - 1024);
    else if (n0 < 2048) src = 1664 + (n0 - 1536);
    else if (n0 < 2560) src = 2176 + (n0 - 2048);
    else if (n0 < 4608) src = 2760 + (n0 - 2560);
    else if (n0 < 4672) src = 512 + (n0 - 4608);
    else if (n0 < 4736) src = 576 + (n0 - 4672);
    else if (n0 < 4800) src = 2688 + (n0 - 4736);
    else if (n0 == 4800) { src = 2752; nvalid = 8; }
    else { src = 0; nvalid = 0; }
}
__device__ __forceinline__ void p0_phase(const Args& a, LAS unsigned char* lds, int wave_s) {
    const int tid0 = otid(wave_s), bid = obid();
    const int wave = tid0 >> 6, lane = tid0 & 63;
    LAS float* scr = (LAS float*)(lds + wave * 16384);
    const int gw = bid * 8 + wave, NGW = gridDim.x * 8;
    constexpr int I_IN = 16 * (NP / 32), I_A = 8 * 32, I_O = 16 * 32, I_P = 4 * 2 * 4, I_L = I_IN + 2 * I_A + I_O + I_P;
    for (int it = gw; it < DEPTH * I_L; it += NGW) {
        const int l = it / I_L; int r = it - l * I_L;
        if (r < I_IN) { const int kb = r / (NP / 32), nb = r % (NP / 32); int src, nv; win_srcmap(nb * 32, src, nv);
            tr_item(a.w_in + (size_t)l * DM * DIN, DIN, DM, kb * 64, src, nv, (h16*)(a.ws + WS_WIN) + ((size_t)l * NP + nb * 32) * DM, scr, lane); continue; }
        r -= I_IN;
        if (r < I_A) { const int kb = r / 32, nb = r % 32;
            tr_item(a.w_a + (size_t)l * 512 * DM, DM, 512, kb * 64, nb * 32, 32, (h16*)(a.ws + WS_WA) + ((size_t)l * DM + nb * 32) * 512, scr, lane); continue; }
        r -= I_A;
        if (r < I_A) { const int kb = r / 32, nb = r % 32;
            tr_item(a.w_b + (size_t)l * 512 * DM, DM, 512, kb * 64, nb * 32, 32, (h16*)(a.ws + WS_WB) + ((size_t)l * DM + nb * 32) * 512, scr, lane); continue; }
        r -= I_A;
        if (r < I_O) { const int kb = r / 32, nb = r % 32;
            tr_item(a.w_out + (size_t)l * DM * DM, DM, DM, kb * 64, nb * 32, 32, (h16*)(a.ws + WS_WO) + ((size_t)l * DM + nb * 32) * DM, scr, lane); continue; }
        r -= I_O;
        { const int g = r / 8, q = r % 8, kb = q / 4, nb = q % 4;
            tr_item(a.pool_w + ((size_t)l * 4 + g) * 128 * 128, 128, 128, kb * 64, nb * 32, 32, (h16*)(a.ws + WS_WP) + (((size_t)l * 4 + g) * 128 + nb * 32) * 128, scr, lane); }
    }
    f32x2* cs = (f32x2*)(a.ws + WS_ROPE);
    for (int i = bid * 512 + tid0; i < T * 32; i += gridDim.x * 512) {
        const int t = i >> 5, j = i & 31;
        const float invf = 1.0f / powf(10000.0f, (float)(2 * j) / 64.0f);
        const float ang = (float)t * invf;
        const double rev = (double)ang * 0.15915494309189533577;
        const double fr = rev - __builtin_rint(rev);
        const float rf = (float)fr;
        f32x2 o; o.x = __builtin_amdgcn_cosf(rf); o.y = __builtin_amdgcn_sinf(rf);
        cs[i] = o;
    }
}

__device__ __forceinline__ void norm_phase(const Args& a, int l, int wave_s) {
    const int tid0 = otid(wave_s), bid = obid();
    const int wave = tid0 >> 6, lane = tid0 & 63;
    const int gw = bid * 8 + wave, NGW = gridDim.x * 8;
    const f32x4* gp = (const f32x4*)(a.norm_g + (size_t)l * DM) + lane;
    f32x4 gn[4];
#pragma unroll
    for (int j = 0; j < 4; ++j) gn[j] = gp[64 * j];
    h16* H = (h16*)(a.ws + WS_H);
    for (int row = gw; row < R; row += 2 * NGW) {
        const int row2 = row + NGW < R ? row + NGW : row;
        const f32x4* xr = (const f32x4*)xrow_src(a, l, row) + lane;
        const f32x4* xr2 = (const f32x4*)xrow_src(a, l, row2) + lane;
        f32x4 v[4], w[4]; float s = 0.f, s2 = 0.f;
#pragma unroll
        for (int j = 0; j < 4; ++j) { v[j] = xr[64 * j]; w[j] = xr2[64 * j]; }
#pragma unroll
        for (int j = 0; j < 4; ++j) { s += (v[j].x * v[j].x + v[j].y * v[j].y) + (v[j].z * v[j].z + v[j].w * v[j].w); s2 += (w[j].x * w[j].x + w[j].y * w[j].y) + (w[j].z * w[j].z + w[j].w * w[j].w); }
        const float rs = 1.0f / sqrtf(wave_sum(s) * (1.0f / DM) + EPS), rs2 = 1.0f / sqrtf(wave_sum(s2) * (1.0f / DM) + EPS);
        u32x2* o8 = (u32x2*)(H + (size_t)row * DM) + lane; u32x2* o82 = (u32x2*)(H + (size_t)row2 * DM) + lane;
#pragma unroll
        for (int j = 0; j < 4; ++j) { u32x2 o; o.x = pk2h(v[j].x * rs * gn[j].x, v[j].y * rs * gn[j].y); o.y = pk2h(v[j].z * rs * gn[j].z, v[j].w * rs * gn[j].w); o8[64 * j] = o; }
        if (row2 != row) {
#pragma unroll
            for (int j = 0; j < 4; ++j) { u32x2 o; o.x = pk2h(w[j].x * rs2 * gn[j].x, w[j].y * rs2 * gn[j].y); o.y = pk2h(w[j].z * rs2 * gn[j].z, w[j].w * rs2 * gn[j].w); o82[64 * j] = o; }
        }
    }
}

template <int W>
__device__ __forceinline__ void pool_stage(const h16* up, int t, LAS h16* dst) {
    const int cnt = (t + 1 < W) ? (t + 1) : W;
    float sum[16], u0[16];
#pragma unroll
    for (int jj = 0; jj < W; ++jj) {
        const bool ok = jj < cnt;
        const h16* p = up - (size_t)(ok ? jj : 0) * NP;
        const h16x8 v0 = *(const h16x8*)p, v1 = *(const h16x8*)(p + 8);
        if (jj == 0) {
#pragma unroll
            for (int e = 0; e < 8; ++e) { u0[e] = (float)v0[e]; u0[8 + e] = (float)v1[e]; sum[e] = u0[e]; sum[8 + e] = u0[8 + e]; }
        } else {
#pragma unroll
            for (int e = 0; e < 8; ++e) { sum[e] += ok ? (float)v0[e] : 0.f; sum[8 + e] += ok ? (float)v1[e] : 0.f; }
        }
    }
    const float ic = 1.0f / (float)cnt;
    u32x4 o0, o1;
    o0.x = pk2h(sum[0] * ic - u0[0], sum[1] * ic - u0[1]); o0.y = pk2h(sum[2] * ic - u0[2], sum[3] * ic - u0[3]);
    o0.z = pk2h(sum[4] * ic - u0[4], sum[5] * ic - u0[5]); o0.w = pk2h(sum[6] * ic - u0[6], sum[7] * ic - u0[7]);
    o1.x = pk2h(sum[8] * ic - u0[8], sum[9] * ic - u0[9]); o1.y = pk2h(sum[10] * ic - u0[10], sum[11] * ic - u0[11]);
    o1.z = pk2h(sum[12] * ic - u0[12], sum[13] * ic - u0[13]); o1.w = pk2h(sum[14] * ic - u0[14], sum[15] * ic - u0[15]);
    *(LAS u32x4*)dst = o0; *(LAS u32x4*)(dst + 8) = o1;
}
template <int W>
__device__ __forceinline__ void pool_loop(const Args& a, int l, LAS unsigned char* lds, int tid, int w, int Gg, int wave, int lane) {
    constexpr int g = W == 2 ? 0 : W == 4 ? 1 : W == 8 ? 2 : 3;
    const h16* PROJ = (const h16*)(a.ws + WS_PROJ);
    h16* BB = (h16*)(a.ws + WS_BB);
    LAS h16* PT0 = (LAS h16*)lds;
    const int fr = lane & 15, fq = lane >> 4, tok = tid >> 3, cseg = tid & 7;
    const int NIT = (R / 64) * 4, step = 4 * Gg;
    const h16* wp = (const h16*)(a.ws + WS_WP) + (size_t)l * 4 * 128 * 128 + ((size_t)g * 128 + 16 * wave + fr) * 128 + 8 * fq;
    h16x8 wf[4];
#pragma unroll
    for (int kk = 0; kk < 4; ++kk) wf[kk] = *(const h16x8*)(wp + 32 * kk);
    const int col = g * 128 + 16 * wave + 4 * fq;
    const f32x4 pb = *(const f32x4*)(a.pool_b + l * 512 + col), ps = *(const f32x4*)(a.pool_s + l * 512 + col);
    constexpr int WP = W < 8 ? W : 8;
    h16x8 v[2 * WP];
#define POOL_LOAD(item_) do { const int _row = ((item_) >> 2) * 64 + tok, _t = _row % T; const int _cnt = (_t + 1 < W) ? (_t + 1) : W; \
        const h16* _up = PROJ + (size_t)_row * NP + C_UB + g * 128 + cseg * 16; \
        _Pragma("unroll") for (int jj = 0; jj < WP; ++jj) { const h16* _p = _up - (size_t)(jj < _cnt ? jj : 0) * NP; v[2 * jj] = *(const h16x8*)_p; v[2 * jj + 1] = *(const h16x8*)(_p + 8); } } while (0)
#define POOL_SUM(item_, buf_) do { const int _row = ((item_) >> 2) * 64 + tok, _t = _row % T; const int _cnt = (_t + 1 < W) ? (_t + 1) : W; \
        float sum[16], u0[16]; \
        _Pragma("unroll") for (int e = 0; e < 8; ++e) { u0[e] = (float)v[0][e]; u0[8 + e] = (float)v[1][e]; sum[e] = u0[e]; sum[8 + e] = u0[8 + e]; } \
        _Pragma("unroll") for (int jj = 1; jj < WP; ++jj) { const bool ok = jj < _cnt; _Pragma("unroll") for (int e = 0; e < 8; ++e) { sum[e] += ok ? (float)v[2 * jj][e] : 0.f; sum[8 + e] += ok ? (float)v[2 * jj + 1][e] : 0.f; } } \
        if (W > WP) { const h16* _up = PROJ + (size_t)_row * NP + C_UB + g * 128 + cseg * 16; \
            _Pragma("unroll") for (int jj = WP; jj < W; ++jj) { const bool ok = jj < _cnt; const h16* _p = _up - (size_t)(ok ? jj : 0) * NP; const h16x8 w0 = *(const h16x8*)_p, w1 = *(const h16x8*)(_p + 8); \
                _Pragma("unroll") for (int e = 0; e < 8; ++e) { sum[e] += ok ? (float)w0[e] : 0.f; sum[8 + e] += ok ? (float)w1[e] : 0.f; } } } \
        const float ic = 1.0f / (float)_cnt; u32x4 o0, o1; \
        o0.x = pk2h(sum[0] * ic - u0[0], sum[1] * ic - u0[1]); o0.y = pk2h(sum[2] * ic - u0[2], sum[3] * ic - u0[3]); \
        o0.z = pk2h(sum[4] * ic - u0[4], sum[5] * ic - u0[5]); o0.w = pk2h(sum[6] * ic - u0[6], sum[7] * ic - u0[7]); \
        o1.x = pk2h(sum[8] * ic - u0[8], sum[9] * ic - u0[9]); o1.y = pk2h(sum[10] * ic - u0[10], sum[11] * ic - u0[11]); \
        o1.z = pk2h(sum[12] * ic - u0[12], sum[13] * ic - u0[13]); o1.w = pk2h(sum[14] * ic - u0[14], sum[15] * ic - u0[15]); \
        LAS h16* _dst = PT0 + (buf_) * (64 * 136) + tok * 136 + cseg * 16; *(LAS u32x4*)_dst = o0; *(LAS u32x4*)(_dst + 8) = o1; } while (0)
    int item = 4 * w + g, buf = 0;
    if (item < NIT) { POOL_LOAD(item); POOL_SUM(item, 0); }
    __syncthreads();
    for (; item < NIT; item += step, buf ^= 1) {
        const int nitem = item + step; const bool has_next = nitem < NIT;
        const int row0 = (item >> 2) * 64;
        if (has_next) POOL_LOAD(nitem);
        h16x4 gb[4];
#pragma unroll
        for (int mt = 0; mt < 4; ++mt) gb[mt] = *(const h16x4*)(PROJ + (size_t)(row0 + 16 * mt + fr) * NP + C_GB + col);
        const LAS h16* PT = PT0 + buf * (64 * 136);
#pragma unroll
        for (int mt = 0; mt < 4; ++mt) {
            f32x4 acc = {0.f, 0.f, 0.f, 0.f};
#pragma unroll
            for (int kk = 0; kk < 4; ++kk) { const h16x8 af = *(const LAS h16x8*)(PT + (16 * mt + fr) * 136 + 32 * kk + 8 * fq);
                acc = __builtin_amdgcn_mfma_f32_16x16x32_f16(wf[kk], af, acc, 0, 0, 0); }
            const size_t row = (size_t)(row0 + 16 * mt + fr);
            u32x2 o; o.x = pk2h((acc[0] + pb[0]) * ps[0] * (float)gb[mt][0], (acc[1] + pb[1]) * ps[1] * (float)gb[mt][1]);
            o.y = pk2h((acc[2] + pb[2]) * ps[2] * (float)gb[mt][2], (acc[3] + pb[3]) * ps[3] * (float)gb[mt][3]);
            *(u32x2*)(BB + row * 512 + col) = o;
        }
        if (has_next) POOL_SUM(nitem, buf ^ 1);
        __syncthreads();
    }
#undef POOL_LOAD
#undef POOL_SUM
}
__device__ __forceinline__ void prep_phase(const Args& a, int l, LAS unsigned char* lds, int wave_s) {
    const int tid = otid(wave_s), bid = obid(), wave = tid >> 6, lane = tid & 63;
    h16* PROJ = (h16*)(a.ws + WS_PROJ);
    const f32x2* cs = (const f32x2*)(a.ws + WS_ROPE);
    {
        h16* KC = (h16*)(a.ws + WS_KC); h16* VC = (h16*)(a.ws + WS_VC); h16* KIC = (h16*)(a.ws + WS_KIC);
        const int gw = bid * 8 + wave, NGW = gridDim.x * 8;
        const int j = lane & 31, isidx = lane >> 5;
        const float g1 = a.kn_g[l * 64 + j], g2 = a.kn_g[l * 64 + 32 + j];
        for (int row0 = gw; row0 < R; row0 += 4 * NGW) {
            float x1[4], x2[4]; f32x2 c[4]; h16* base[4]; bool ok[4]; int rowi[4]; h16 vv[4];
#pragma unroll
            for (int r = 0; r < 4; ++r) { const int rr = row0 + r * NGW; ok[r] = rr < R; const int row = ok[r] ? rr : row0; rowi[r] = row;
                base[r] = PROJ + (size_t)row * NP + (isidx ? C_KI : C_K);
                x1[r] = (float)base[r][j]; x2[r] = (float)base[r][j + 32]; c[r] = cs[(row % T) * 32 + j]; vv[r] = PROJ[(size_t)row * NP + C_V + lane]; }
#pragma unroll
            for (int r = 0; r < 4; ++r) {
                float ss = x1[r] * x1[r] + x2[r] * x2[r];
#pragma unroll
                for (int o = 1; o < 32; o <<= 1) ss += __shfl_xor(ss, o);
                float y1 = x1[r], y2 = x2[r];
                if (!isidx) { const float rs = 1.0f / sqrtf(ss * (1.0f / 64.0f) + EPS); y1 *= rs * g1; y2 *= rs * g2; }
                if (ok[r]) { const h16 o1 = (h16)(y1 * c[r].x - y2 * c[r].y), o2 = (h16)(y2 * c[r].x + y1 * c[r].y);
                    if (isidx) { const int bb = rowi[r] / T, tt = rowi[r] - bb * T;
                        KIC[((size_t)(bb * 8 + (j >> 3)) * T + tt) * 8 + (j & 7)] = o1; KIC[((size_t)(bb * 8 + 4 + (j >> 3)) * T + tt) * 8 + (j & 7)] = o2; }
                    else { h16* dst = KC + (size_t)rowi[r] * 64; dst[j] = o1; dst[j + 32] = o2; }
                    VC[(size_t)rowi[r] * 64 + lane] = vv[r]; }
            }
        }
    }
    {
        const int G = (int)gridDim.x, t0 = (G * 40) >> 8, t1 = (G * 90) >> 8, t2 = (G * 156) >> 8;
        if (t0 >= 1 && t1 > t0 && t2 > t1 && G > t2) {
            if (bid < t0) pool_loop<2>(a, l, lds, tid, bid, t0, wave, lane); else if (bid < t1) pool_loop<4>(a, l, lds, tid, bid - t0, t1 - t0, wave, lane);
            else if (bid < t2) pool_loop<8>(a, l, lds, tid, bid - t1, t2 - t1, wave, lane); else pool_loop<16>(a, l, lds, tid, bid - t2, G - t2, wave, lane);
        }
    }
}

__device__ __forceinline__ float wave_min(float v) {
#pragma unroll
    for (int o = 1; o < 64; o <<= 1) v = fminf(v, __shfl_xor(v, o));
    return v;
}
__device__ __forceinline__ float wave_max(float v) {
#pragma unroll
    for (int o = 1; o < 64; o <<= 1) v = fmaxf(v, __shfl_xor(v, o));
    return v;
}
__device__ __forceinline__ int mbcnt(unsigned long long m) { return (int)__builtin_amdgcn_mbcnt_hi((unsigned)(m >> 32), __builtin_amdgcn_mbcnt_lo((unsigned)m, 0u)); }

__device__ __forceinline__ void select_topk(const LAS float* sc, int n, LAS unsigned* hist, LAS unsigned short* sel, int lane, float lo, float hi) {
    LAS unsigned short* cand = (LAS unsigned short*)hist;
    const LAS f32x4* sc4 = (const LAS f32x4*)sc;
    const int n4 = n >> 2;
    int need = 256, nsel = 0;
    const int nit = (n + 63) >> 6, nit4 = (n4 + 63) >> 6;
    for (int iter = 0; iter < 64; ++iter) {
        if (!(lo < hi)) {
            for (int it = 0; it < nit; ++it) { const int idx = it * 64 + lane; const bool act = idx < n && sc[idx < n ? idx : 0] == lo;
                const unsigned long long mk = __ballot(act); const int pos = nsel + mbcnt(mk);
                if (act && pos < 256) sel[pos] = (unsigned short)idx;
                nsel += __popcll(mk); }
            break;
        }
#pragma unroll
        for (int j = 0; j < 8; ++j) hist[lane * 8 + j] = 0u;
        LDS_FENCE();
        const float scale = 512.0f / (hi - lo), nls = -lo * scale;
        if (iter == 0) {
#pragma unroll 2
            for (int q = lane; q < n4; q += 64) { const f32x4 v4 = sc4[q];
#pragma unroll
                for (int e = 0; e < 4; ++e) { int bin = (int)__builtin_fmaf(v4[e], scale, nls); bin = bin > 511 ? 511 : bin;
                    __hip_atomic_fetch_add(hist + bin, 1u, __ATOMIC_RELAXED, __HIP_MEMORY_SCOPE_WORKGROUP); } }
        } else {
#pragma unroll 2
            for (int q = lane; q < n4; q += 64) { const f32x4 v4 = sc4[q];
#pragma unroll
                for (int e = 0; e < 4; ++e) { const float v = v4[e];
                    if (v >= lo && v <= hi) { int bin = (int)__builtin_fmaf(v, scale, nls); bin = bin > 511 ? 511 : bin;
                        __hip_atomic_fetch_add(hist + bin, 1u, __ATOMIC_RELAXED, __HIP_MEMORY_SCOPE_WORKGROUP); } } }
        }
        LDS_FENCE();
        unsigned wd[8]; int tot = 0;
#pragma unroll
        for (int j = 0; j < 8; ++j) { wd[j] = hist[lane * 8 + j]; tot += (int)wd[j]; }
        int suf = tot;
#pragma unroll
        for (int o = 1; o < 64; o <<= 1) { const int tq = __shfl_down(suf, o); suf += (lane + o < 64) ? tq : 0; }
        const int above = suf - tot;
        const bool has = (above < need) && (suf >= need);
        int bstar = 0, cgt = 0;
        {
            int run = above; bool found = false;
#pragma unroll
            for (int bb = 7; bb >= 0; --bb) { const int c = (int)wd[bb];
                if (!found && run + c >= need) { found = true; bstar = lane * 8 + bb; cgt = run; }
                run += c; }
        }
        const unsigned long long hm = __ballot(has);
        const int src = (int)__builtin_ctzll(hm ? hm : 1ull);
        bstar = __shfl(bstar, src); cgt = __shfl(cgt, src);
        LDS_FENCE();
        float lo2 = 3.0e38f, hi2 = -3.0e38f; int ncand = 0;
        if (iter == 0) {
            const float thr_gt = bstar >= 511 ? 3.0e38f : (float)(bstar + 1), thr_eq = bstar == 0 ? -3.0e38f : (float)bstar;
            int cl = 0;
#pragma unroll 2
            for (int q = lane; q < n4; q += 64) { const f32x4 v4 = sc4[q];
#pragma unroll
                for (int e = 0; e < 4; ++e) cl += (__builtin_fmaf(v4[e], scale, nls) >= thr_gt) ? 1 : 0; }
            int incl = cl;
#pragma unroll
            for (int o = 1; o < 64; o <<= 1) { const int tq = __shfl_up(incl, o); incl += (lane >= o) ? tq : 0; }
            int wpos = nsel + incl - cl;
            for (int it = 0; it < nit4; ++it) { const int q = it * 64 + lane; const bool inr = q < n4; const f32x4 v4 = sc4[inr ? q : 0];
                bool eqv[4]; bool anyeq = false;
#pragma unroll
                for (int e = 0; e < 4; ++e) { const float t = __builtin_fmaf(v4[e], scale, nls); const bool gt = inr && t >= thr_gt; eqv[e] = inr && !gt && t >= thr_eq; anyeq = anyeq || eqv[e];
                    if (gt) { sel[wpos] = (unsigned short)(4 * q + e); ++wpos; } }
                if (__ballot(anyeq)) {
#pragma unroll
                    for (int e = 0; e < 4; ++e) { const unsigned long long me = __ballot(eqv[e]);
                        if (eqv[e]) { const int p = ncand + mbcnt(me); if (p < 1024) cand[p] = (unsigned short)(4 * q + e); lo2 = fminf(lo2, v4[e]); hi2 = fmaxf(hi2, v4[e]); }
                        ncand += __popcll(me); } } }
            nsel += cgt;
        } else {
        for (int it = 0; it < nit4; ++it) { const int q = it * 64 + lane; const bool inr = q < n4; const f32x4 v4 = sc4[inr ? q : 0];
            bool eqv[4]; bool anyeq = false;
#pragma unroll
            for (int e = 0; e < 4; ++e) { const float v = v4[e]; const int idx = 4 * q + e;
                const bool act = inr && v >= lo && v <= hi;
                int bin = (int)__builtin_fmaf(v, scale, nls); bin = bin > 511 ? 511 : bin;
                const bool gt = act && bin > bstar; eqv[e] = act && bin == bstar; anyeq = anyeq || eqv[e];
                const unsigned long long mg = __ballot(gt);
                if (gt) sel[nsel + mbcnt(mg)] = (unsigned short)idx;
                nsel += __popcll(mg); }
            if (__ballot(anyeq)) {
#pragma unroll
                for (int e = 0; e < 4; ++e) { const unsigned long long me = __ballot(eqv[e]);
                    if (eqv[e]) { const int p = ncand + mbcnt(me); if (p < 1024) cand[p] = (unsigned short)(4 * q + e); lo2 = fminf(lo2, v4[e]); hi2 = fmaxf(hi2, v4[e]); }
                    ncand += __popcll(me); } } }
        }
        need -= cgt;
        LDS_FENCE();
        if (ncand == need) { for (int i = lane; i < ncand; i += 64) sel[nsel + i] = cand[i]; break; }
        if (ncand <= 256) {
            const int rounds = (ncand + 63) >> 6;
            for (int rd = 0; rd < rounds; ++rd) { const int i = rd * 64 + lane; const bool ok = i < ncand;
                const int idx = cand[ok ? i : 0]; const float v = sc[idx]; int rank = 0;
                for (int j = 0; j < ncand; ++j) { const int ij = cand[j]; const float vj = sc[ij]; rank += (vj > v || (vj == v && ij < idx)) ? 1 : 0; }
                if (ok && rank < need) sel[nsel + rank] = (unsigned short)idx; }
            break;
        }
        lo = wave_min(lo2); hi = wave_max(hi2);
    }
    LDS_FENCE();
}

__device__ __forceinline__ void attn_phase(const Args& a, int l, LAS unsigned char* lds, int wave_s) {
    const int tid = otid(wave_s), bid = obid(), wave = __builtin_amdgcn_readfirstlane(tid >> 6), lane0 = tid & 63;
    LAS float* SC = (LAS float*)(lds + L_SC);
    LAS unsigned char* HQ = lds + L_HQ;
    LAS unsigned short* sel = (LAS unsigned short*)(lds + L_SEL) + wave * 256;
    LAS h16* QA = (LAS h16*)(lds + L_QA) + wave * 512;
    const h16* PROJ = (const h16*)(a.ws + WS_PROJ);
    const h16* KC = (const h16*)(a.ws + WS_KC); const h16* VC = (const h16*)(a.ws + WS_VC); const h16* KIC = (const h16*)(a.ws + WS_KIC);
    h16* AA = (h16*)(a.ws + WS_AA);
    const f32x2* cs = (const f32x2*)(a.ws + WS_ROPE);
    const int xg = bid & 7; constexpr int NJ = 2 * (T / 8);
    unsigned* cntp = (unsigned*)(a.ws + WS_BAR) + 4096 + (l * 8 + xg) * 64;
    volatile LAS unsigned* TK = (volatile LAS unsigned*)(lds + L_BARST + 16);
    if (wave == 0 && lane0 == 0) TK[0] = __hip_atomic_fetch_add(cntp, 1u, __ATOMIC_RELAXED, __HIP_MEMORY_SCOPE_AGENT);
    __syncthreads();
    int cur = __builtin_amdgcn_readfirstlane((int)TK[0]);
    h16x8 n_xqi, n_xq; h16 n_wi = (h16)0.f; f32x4 n_rc[4]; h16x8 n_B[4];
    {
        const int lane = lane0;
        const int j = cur < NJ ? cur : 0; const int b = xg + 8 * (j & 1), g = (T / 8 - 1) - (j >> 1), t = 8 * g + wave; const size_t row = (size_t)(b * T + t);
        n_xqi = *(const h16x8*)(PROJ + row * NP + C_QI + lane * 8); n_xq = *(const h16x8*)(PROJ + row * NP + C_Q + lane * 8);
        if (lane < 8) n_wi = PROJ[row * NP + C_WI + lane];
#pragma unroll
        for (int e = 0; e < 4; ++e) n_rc[e] = *(const f32x4*)(cs + t * 32 + (lane & 3) * 8 + 2 * e);
        { const h16* kp = KIC + ((size_t)(b * 8 + (lane >> 5)) * T + wave * 32 + (lane & 31)) * 8;
#pragma unroll
          for (int kk = 0; kk < 4; ++kk) n_B[kk] = *(const h16x8*)(kp + (size_t)kk * 2 * T * 8); }
    }
    for (int it = 0; cur < NJ; ++it) {
        if (wave == 0 && lane0 == 0) TK[(it + 1) & 1] = __hip_atomic_fetch_add(cntp, 1u, __ATOMIC_RELAXED, __HIP_MEMORY_SCOPE_AGENT);
        const int b = xg + 8 * (cur & 1), g = (T / 8 - 1) - (cur >> 1);
        const int t0 = 8 * g, n = (t0 < NMETA) ? NMETA : NMETA + 64 * (1 + ((t0 - NMETA) >> 6));
        const int rowbase = b * T, t = t0 + wave;
        const size_t myrow = (size_t)(rowbase + t);
        const int cnt = n < 256 ? n : 256;
        const char* KCb = (const char*)(KC + (size_t)rowbase * 64); const char* VCb = (const char*)(VC + (size_t)rowbase * 64);
        {
            int lane1 = lane0; asm volatile("" : "+v"(lane1)); const int lane = lane1;
            const int piece = lane & 7;
            LAS h16* QS = (LAS h16*)HQ; LAS float* WSs = (LAS float*)(HQ + 8192);
            float c[8], sn[8];
#pragma unroll
            for (int e = 0; e < 4; ++e) { c[2 * e] = n_rc[e][0]; sn[2 * e] = n_rc[e][1]; c[2 * e + 1] = n_rc[e][2]; sn[2 * e + 1] = n_rc[e][3]; }
            if (n > 256) {
                float y[8];
#pragma unroll
                for (int e = 0; e < 8; ++e) { const float xe = (float)n_xqi[e], xp = __shfl_xor(xe, 4); y[e] = piece < 4 ? xe * c[e] - xp * sn[e] : xe * c[e] + xp * sn[e]; }
                u32x4 o; o.x = pk2h(y[0], y[1]); o.y = pk2h(y[2], y[3]); o.z = pk2h(y[4], y[5]); o.w = pk2h(y[6], y[7]);
                *(LAS u32x4*)(QS + wave * 512 + lane * 8) = o;
                if (lane < 8) WSs[wave * 8 + lane] = (float)n_wi * 0.04419417382415922f;
            }
            {
                const f32x4 g0 = *(const f32x4*)(a.qn_g + l * 64 + piece * 8), g1 = *(const f32x4*)(a.qn_g + l * 64 + piece * 8 + 4);
                float xf[8], ss = 0.f;
#pragma unroll
                for (int e = 0; e < 8; ++e) { xf[e] = (float)n_xq[e]; ss += xf[e] * xf[e]; }
                ss += __shfl_xor(ss, 1); ss += __shfl_xor(ss, 2); ss += __shfl_xor(ss, 4);
                const float rs = 1.0f / sqrtf(ss * (1.0f / 64.0f) + EPS);
                float y[8];
#pragma unroll
                for (int e = 0; e < 8; ++e) { const float ye = xf[e] * rs * (e < 4 ? g0[e & 3] : g1[e & 3]), yp = __shfl_xor(ye, 4); y[e] = piece < 4 ? ye * c[e] - yp * sn[e] : ye * c[e] + yp * sn[e]; }
                u32x4 o; o.x = pk2h(y[0], y[1]); o.y = pk2h(y[2], y[3]); o.z = pk2h(y[4], y[5]); o.w = pk2h(y[6], y[7]);
                *(LAS u32x4*)(QA + lane * 8) = o;
            }
        }
        if (n > 256) {
            LAS h16* QS = (LAS h16*)HQ; LAS float* WSs = (LAS float*)(HQ + 8192);
            __syncthreads();
            {
                int lane2 = lane0; asm volatile("" : "+v"(lane2)); const int lane = lane2;
                const int i = lane & 31, gg = i >> 3, hr = (i >> 2) & 1, jj = i & 3, hg = lane >> 5;
                const int qrow = (gg >> 1) * 2 + hr, head = (gg & 1) * 4 + jj;
                h16x8 Af[2][4];
#pragma unroll
                for (int rt = 0; rt < 2; ++rt)
#pragma unroll
                    for (int kk = 0; kk < 4; ++kk) Af[rt][kk] = *(const LAS h16x8*)(QS + (rt * 4 + qrow) * 512 + head * 64 + kk * 16 + hg * 8);
                f32x4 wv[2][2][2];
#pragma unroll
                for (int rt = 0; rt < 2; ++rt)
#pragma unroll
                    for (int hf = 0; hf < 2; ++hf) { const int q = rt * 4 + hf * 2 + hg; wv[rt][hf][0] = *(const LAS f32x4*)(WSs + q * 8); wv[rt][hf][1] = *(const LAS f32x4*)(WSs + q * 8 + 4); }
                const int ntile = (n + 31) >> 5;
                float mn0 = 3.0e38f, mn1 = 3.0e38f, mn2 = 3.0e38f, mn3 = 3.0e38f, mx0 = -3.0e38f, mx1 = -3.0e38f, mx2 = -3.0e38f, mx3 = -3.0e38f;
                h16x8 Bn[4];
#pragma unroll
                for (int kk = 0; kk < 4; ++kk) Bn[kk] = n_B[kk];
                for (int tile = wave; tile < ntile; tile += 8) {
                    const int key = tile * 32 + i;
                    h16x8 Bf[4];
#pragma unroll
                    for (int kk = 0; kk < 4; ++kk) Bf[kk] = Bn[kk];
                    { const int keyn = key + 256, keyc = keyn < n ? keyn : n - 1;
                      const h16* kp = KIC + ((size_t)(b * 8 + hg) * T + keyc) * 8;
#pragma unroll
                      for (int kk = 0; kk < 4; ++kk) Bn[kk] = *(const h16x8*)(kp + (size_t)kk * 2 * T * 8); }
                    f32x16 acc0, acc1;
#pragma unroll
                    for (int e = 0; e < 16; ++e) { acc0[e] = 0.f; acc1[e] = 0.f; }
#pragma unroll
                    for (int kk = 0; kk < 4; ++kk) { acc0 = __builtin_amdgcn_mfma_f32_32x32x16_f16(Af[0][kk], Bf[kk], acc0, 0, 0, 0); acc1 = __builtin_amdgcn_mfma_f32_32x32x16_f16(Af[1][kk], Bf[kk], acc1, 0, 0, 0); }
                    float s00 = 0.f, s01 = 0.f, s10 = 0.f, s11 = 0.f;
#pragma unroll
                    for (int r = 0; r < 8; ++r) { const float w0 = wv[0][0][r >> 2][r & 3], w1 = wv[0][1][r >> 2][r & 3], w2 = wv[1][0][r >> 2][r & 3], w3 = wv[1][1][r >> 2][r & 3];
                        s00 += w0 * fmaxf(acc0[r], 0.f); s01 += w1 * fmaxf(acc0[8 + r], 0.f); s10 += w2 * fmaxf(acc1[r], 0.f); s11 += w3 * fmaxf(acc1[8 + r], 0.f); }
                    SC[(0 + hg) * SCW + key] = s00; SC[(2 + hg) * SCW + key] = s01; SC[(4 + hg) * SCW + key] = s10; SC[(6 + hg) * SCW + key] = s11;
                    mn0 = fminf(mn0, s00); mx0 = fmaxf(mx0, s00); mn1 = fminf(mn1, s01); mx1 = fmaxf(mx1, s01);
                    mn2 = fminf(mn2, s10); mx2 = fmaxf(mx2, s10); mn3 = fminf(mn3, s11); mx3 = fmaxf(mx3, s11);
                }
#pragma unroll
                for (int o = 1; o < 32; o <<= 1) { mn0 = fminf(mn0, __shfl_xor(mn0, o)); mx0 = fmaxf(mx0, __shfl_xor(mx0, o)); mn1 = fminf(mn1, __shfl_xor(mn1, o)); mx1 = fmaxf(mx1, __shfl_xor(mx1, o));
                    mn2 = fminf(mn2, __shfl_xor(mn2, o)); mx2 = fmaxf(mx2, __shfl_xor(mx2, o)); mn3 = fminf(mn3, __shfl_xor(mn3, o)); mx3 = fmaxf(mx3, __shfl_xor(mx3, o)); }
                if (i == 0) { LAS f32x2* MM = (LAS f32x2*)(lds + L_MM) + wave * 8;
                    MM[0 + hg] = (f32x2){mn0, mx0}; MM[2 + hg] = (f32x2){mn1, mx1}; MM[4 + hg] = (f32x2){mn2, mx2}; MM[6 + hg] = (f32x2){mn3, mx3}; }
            }
            __syncthreads();
            {
                float lo = 3.0e38f, hi = -3.0e38f;
                const LAS f32x2* MM = (const LAS f32x2*)(lds + L_MM);
#pragma unroll
                for (int w8 = 0; w8 < 8; ++w8) { const f32x2 m = MM[w8 * 8 + wave]; lo = fminf(lo, m[0]); hi = fmaxf(hi, m[1]); }
                int lane4 = lane0; asm volatile("" : "+v"(lane4));
                select_topk(SC + wave * SCW, n, (LAS unsigned*)(HQ + wave * 2048), sel, lane4, lo, hi);
            }
        } else {
            for (int i = lane0; i < n; i += 64) sel[i] = (unsigned short)i;
            LDS_FENCE();
            __syncthreads();
        }
        const int nxt = __builtin_amdgcn_readfirstlane((int)TK[(it + 1) & 1]);
        int lane5 = lane0; asm volatile("" : "+v"(lane5));
        {
        const int lane = lane5, fr = lane & 15, fq = lane >> 4, piece = lane & 7;
        h16x8 Qf[2];
        Qf[0] = *(const LAS h16x8*)(QA + (fr & 7) * 64 + fq * 8); Qf[1] = *(const LAS h16x8*)(QA + (fr & 7) * 64 + 32 + fq * 8);
        f32x4 s[16];
        u32x4 vr[16];
#define ATT_KEYS(keys, c) do { const int _p0 = (lane >> 3) * 32 + 16 * (c); \
            if (cnt < 256) { _Pragma("unroll") for (int i = 0; i < 16; ++i) { const int _p = _p0 + i; keys[i] = sel[_p < cnt ? _p : cnt - 1]; } } \
            else { const u32x4 _w0 = *(const LAS u32x4*)(sel + _p0), _w1 = *(const LAS u32x4*)(sel + _p0 + 8); \
                _Pragma("unroll") for (int i = 0; i < 4; ++i) { keys[2 * i] = (int)(_w0[i] & 0xffffu); keys[2 * i + 1] = (int)(_w0[i] >> 16); keys[8 + 2 * i] = (int)(_w1[i] & 0xffffu); keys[8 + 2 * i + 1] = (int)(_w1[i] >> 16); } } } while (0)
        LAS unsigned char* VS = (LAS unsigned char*)(SC + wave * SCW);
        {
            u32x4 kr[2][16];
#pragma unroll
            for (int c = 0; c < 2; ++c) {
                int keys[16];
#pragma unroll
                ATT_KEYS(keys, c);
                __builtin_amdgcn_sched_barrier(0);
#pragma unroll
                for (int i = 0; i < 16; ++i) kr[c][i] = *(const u32x4*)(KCb + (unsigned)(keys[i] * 128 + piece * 16));
                __builtin_amdgcn_sched_barrier(0);
            }
#pragma unroll
            for (int c = 0; c < 2; ++c) {
#pragma unroll
                for (int i = 0; i < 16; ++i) { const int sl = 8 * i + (lane >> 3); *(LAS u32x4*)(VS + sl * 128 + ((piece ^ ((sl >> 1) & 7)) * 16)) = kr[c][i]; }
                LDS_FENCE();
#pragma unroll
                for (int tl = 0; tl < 8; ++tl) {
                    const int sl = 16 * tl + fr, sw = (sl >> 1) & 7;
                    const h16x8 a0 = *(const LAS h16x8*)(VS + sl * 128 + ((fq ^ sw) * 16)), a1 = *(const LAS h16x8*)(VS + sl * 128 + (((4 + fq) ^ sw) * 16));
                    f32x4 z = {0.f, 0.f, 0.f, 0.f};
                    z = __builtin_amdgcn_mfma_f32_16x16x32_f16(a0, Qf[0], z, 0, 0, 0);
                    s[8 * c + tl] = __builtin_amdgcn_mfma_f32_16x16x32_f16(a1, Qf[1], z, 0, 0, 0);
                }
                LDS_ORDER();
            }
            __builtin_amdgcn_sched_barrier(0);
            int keysv[16];
#pragma unroll
            ATT_KEYS(keysv, 0);
            __builtin_amdgcn_sched_barrier(0);
#pragma unroll
            for (int i = 0; i < 16; ++i) vr[i] = *(const u32x4*)(VCb + (unsigned)(keysv[i] * 128 + piece * 16));
            __builtin_amdgcn_sched_barrier(0);
        }
        float mx = -3.0e38f;
        if (cnt < 256) {
#pragma unroll
            for (int tau = 0; tau < 16; ++tau)
#pragma unroll
                for (int j = 0; j < 4; ++j) { const int x = 4 * fq + j, pos = (x & 7) * 32 + (tau >> 3) * 16 + 2 * (tau & 7) + (x >> 3); if (pos >= cnt) s[tau][j] = -1.0e30f; }
        }
#pragma unroll
        for (int tau = 0; tau < 16; ++tau)
#pragma unroll
            for (int j = 0; j < 4; ++j) mx = fmaxf(mx, s[tau][j]);
        mx = fmaxf(mx, __shfl_xor(mx, 16)); mx = fmaxf(mx, __shfl_xor(mx, 32));
        float sum = 0.f;
        const float cscale = 0.125f * 1.44269504088896340736f;
        const float mxc = mx * cscale;
#pragma unroll
        for (int tau = 0; tau < 16; ++tau)
#pragma unroll
            for (int j = 0; j < 4; ++j) { const float p = __builtin_amdgcn_exp2f(__builtin_fmaf(s[tau][j], cscale, -mxc)); s[tau][j] = p; sum += p; }
        sum += __shfl_xor(sum, 16); sum += __shfl_xor(sum, 32);
        const float inv = 1.0f / sum;
        h16x8 Pf[8];
#pragma unroll
        for (int kk = 0; kk < 8; ++kk)
#pragma unroll
            for (int e = 0; e < 4; ++e) { Pf[kk][e] = (h16)s[2 * kk][e]; Pf[kk][4 + e] = (h16)s[2 * kk + 1][e]; }
        f32x4 o[4];
#pragma unroll
        for (int d = 0; d < 4; ++d) o[d] = (f32x4){0.f, 0.f, 0.f, 0.f};
        const int lg = lane & 15;
        h16x8 gav;
#pragma unroll
        for (int c = 0; c < 2; ++c) {
#pragma unroll
            for (int i = 0; i < 16; ++i) { const int sl = 8 * i + (lane >> 3);
                *(LAS u32x4*)(VS + sl * 128 + (((piece >> 1) ^ ((sl >> 1) & 3)) * 32) + (piece & 1) * 16) = vr[i]; }
            if (c == 0) {
                int keys[16];
#pragma unroll
                ATT_KEYS(keys, 1);
                __builtin_amdgcn_sched_barrier(0);
#pragma unroll
                for (int i = 0; i < 16; ++i) vr[i] = *(const u32x4*)(VCb + (unsigned)(keys[i] * 128 + piece * 16));
                gav = *(const h16x8*)(PROJ + myrow * NP + C_GA + lane * 8);
                __builtin_amdgcn_sched_barrier(0);
            } else {
                {
                    const int nj = nxt < NJ ? nxt : cur;
                    const int nb = xg + 8 * (nj & 1), ng = (T / 8 - 1) - (nj >> 1), nt = 8 * ng + wave; const size_t nrow = (size_t)(nb * T + nt);
                    n_xqi = *(const h16x8*)(PROJ + nrow * NP + C_QI + lane * 8); n_xq = *(const h16x8*)(PROJ + nrow * NP + C_Q + lane * 8);
                    if (lane < 8) n_wi = PROJ[nrow * NP + C_WI + lane];
#pragma unroll
                    for (int e = 0; e < 4; ++e) n_rc[e] = *(const f32x4*)(cs + nt * 32 + (lane & 3) * 8 + 2 * e);
                    { const h16* kp = KIC + ((size_t)(nb * 8 + (lane >> 5)) * T + wave * 32 + (lane & 31)) * 8;
#pragma unroll
                      for (int kk = 0; kk < 4; ++kk) n_B[kk] = *(const h16x8*)(kp + (size_t)kk * 2 * T * 8); }
                }
                __builtin_amdgcn_sched_barrier(0);
            }
            LDS_FENCE();
            {
                h16x8 vfa[4], vfb[4];
#define PV_READ(dst, kk_) do { const int rowA = 32 * (kk_) + 4 * fq + (lg >> 2), rowB = rowA + 16; _Pragma("unroll") for (int d = 0; d < 4; ++d) { \
                    const fp16x4 vlo = __builtin_amdgcn_ds_read_tr16_b64_v4f16((LAS fp16x4*)(VS + rowA * 128 + ((d ^ ((rowA >> 1) & 3)) * 32) + (lg & 3) * 8)); \
                    const fp16x4 vhi = __builtin_amdgcn_ds_read_tr16_b64_v4f16((LAS fp16x4*)(VS + rowB * 128 + ((d ^ ((rowB >> 1) & 3)) * 32) + (lg & 3) * 8)); \
                    const h16x4 wl = __builtin_bit_cast(h16x4, vlo), wh = __builtin_bit_cast(h16x4, vhi); \
                    dst[d][0] = wl[0]; dst[d][1] = wl[1]; dst[d][2] = wl[2]; dst[d][3] = wl[3]; dst[d][4] = wh[0]; dst[d][5] = wh[1]; dst[d][6] = wh[2]; dst[d][7] = wh[3]; } } while (0)
#define PV_MMA(src, kk_) do { _Pragma("unroll") for (int d = 0; d < 4; ++d) o[d] = __builtin_amdgcn_mfma_f32_16x16x32_f16(Pf[4 * c + (kk_)], src[d], o[d], 0, 0, 0); } while (0)
                PV_READ(vfa, 0); __builtin_amdgcn_sched_barrier(0);
                PV_READ(vfb, 1); __builtin_amdgcn_sched_barrier(0);
                PV_MMA(vfa, 0);  __builtin_amdgcn_sched_barrier(0);
                PV_READ(vfa, 2); __builtin_amdgcn_sched_barrier(0);
                PV_MMA(vfb, 1);  __builtin_amdgcn_sched_barrier(0);
                PV_READ(vfb, 3); __builtin_amdgcn_sched_barrier(0);
                PV_MMA(vfa, 2);  __builtin_amdgcn_sched_barrier(0);
                PV_MMA(vfb, 3);  __builtin_amdgcn_sched_barrier(0);
#undef PV_READ
#undef PV_MMA
            }
            LDS_ORDER();
        }
        LAS h16* OT = (LAS h16*)VS; LAS float* IV = (LAS float*)(VS + 1024);
        if (fq < 2) {
#pragma unroll
            for (int d = 0; d < 4; ++d)
#pragma unroll
                for (int j = 0; j < 4; ++j) OT[(4 * fq + j) * 64 + 16 * d + fr] = (h16)(o[d][j] * 0.00390625f);
        }
        if (lane < 8) IV[lane] = inv * 256.0f;
        LDS_FENCE();
        {
            const float hinv = IV[lane >> 3];
            const h16x8 ov = *(const LAS h16x8*)(OT + lane * 8);
            float r[8];
#pragma unroll
            for (int e = 0; e < 8; ++e) r[e] = (float)ov[e] * hinv * (float)gav[e];
            u32x4 ow; ow.x = pk2h(r[0], r[1]); ow.y = pk2h(r[2], r[3]); ow.z = pk2h(r[4], r[5]); ow.w = pk2h(r[6], r[7]);
            *(u32x4*)(AA + myrow * 512 + lane * 8) = ow;
        }
        }
        __syncthreads();
        cur = nxt;
    }
}

#define XB_TMO      128
#define XB_XCNT(j)  (256  + 64 * (j))
#define XB_XSUB(j)  (1280 + 64 * (j))
#define XB_XGEN(j)  (2304 + 64 * (j))
#define XB_TOP      3328
#define XB_TOPGEN   3392
#define XCD_BAR_WORDS 3456
#define XB_SPIN_CAP (1u << 20)
__device__ __forceinline__ unsigned xb_ld(unsigned* p)              { return __hip_atomic_load(p, __ATOMIC_RELAXED, __HIP_MEMORY_SCOPE_AGENT); }
__device__ __forceinline__ unsigned xb_add(unsigned* p, unsigned v) { return __hip_atomic_fetch_add(p, v, __ATOMIC_RELAXED, __HIP_MEMORY_SCOPE_AGENT); }
__device__ __forceinline__ unsigned xb_xcc_id() { return (unsigned)__builtin_amdgcn_s_getreg((3 << 11) | 20) & 0xFu; }
#define XB_SPIN(cond, bar) do { unsigned _sp = 0; while (cond) { __builtin_amdgcn_s_sleep(1); \
    if ((++_sp & 255u) == 0u) { if (xb_ld(&(bar)[XB_TMO])) break; if (_sp > XB_SPIN_CAP) { atomicAdd(&(bar)[XB_TMO], 1u); break; } } } } while (0)
struct XcdBarrier { unsigned* bar; unsigned x; volatile LAS unsigned* st; };
__device__ __forceinline__ XcdBarrier xcd_barrier_post(unsigned* bar, volatile LAS unsigned* st) {
    XcdBarrier b; b.bar = bar; b.x = xb_xcc_id(); b.st = st;
    if (threadIdx.x == 0) (void)xb_add(&bar[XB_XCNT(b.x)], 1u);
    return b;
}
__device__ __forceinline__ void xcd_barrier_complete(unsigned* bar, unsigned x, unsigned& nloc, unsigned& nx) {
    const unsigned G = gridDim.x * gridDim.y * gridDim.z;
    unsigned sum, cnt, mine, sp = 0u;
    for (;;) {
        sum = 0u; cnt = 0u; mine = 0u;
#pragma unroll
        for (unsigned j = 0; j < 16; ++j) { const unsigned c = xb_ld(&bar[XB_XCNT(j)]); sum += c; cnt += (c > 0u) ? 1u : 0u; mine = (j == x) ? c : mine; }
        if (sum == G) break;
        __builtin_amdgcn_s_sleep(1);
        if ((++sp & 255u) == 0u) { if (xb_ld(&bar[XB_TMO])) break; if (sp > XB_SPIN_CAP) { atomicAdd(&bar[XB_TMO], 1u); break; } }
    }
    nloc = mine > 0u ? mine : 1u; nx = cnt > 0u ? cnt : 1u;
}
__device__ __forceinline__ void xcd_barrier(const XcdBarrier& b, int wave_s) {
    asm volatile("s_waitcnt vmcnt(0)" ::: "memory");
    __syncthreads();
    if (wave_s == 0 && olane() == 0) {
        unsigned* bar = b.bar;
        __builtin_amdgcn_s_waitcnt(0);
        unsigned nloc = b.st[0], nx = b.st[1];
        if (nloc == 0u) { xcd_barrier_complete(bar, b.x, nloc, nx); b.st[0] = nloc; b.st[1] = nx; }
        const unsigned old = xb_add(&bar[XB_XSUB(b.x)], 1u);
        const unsigned gen = old / nloc;
        if (old + 1u == (gen + 1u) * nloc) {
            __builtin_amdgcn_fence(__ATOMIC_RELEASE, "agent");
            asm volatile("s_waitcnt vmcnt(0)" ::: "memory");
            const unsigned og = xb_add(&bar[XB_TOP], 1u);
            const unsigned tg = og / nx;
            if (og + 1u == (tg + 1u) * nx) xb_add(&bar[XB_TOPGEN], 1u);
            else XB_SPIN(xb_ld(&bar[XB_TOPGEN]) == tg, bar);
            __builtin_amdgcn_fence(__ATOMIC_ACQUIRE, "agent");
            xb_add(&bar[XB_XGEN(b.x)], 1u);
            asm volatile("s_waitcnt vmcnt(0)" ::: "memory");
        } else {
            XB_SPIN(xb_ld(&bar[XB_XGEN(b.x)]) == gen, bar);
            __builtin_amdgcn_fence(__ATOMIC_ACQUIRE, "agent");
            asm volatile("s_waitcnt vmcnt(0)" ::: "memory");
        }
    }
    __syncthreads();
}

__device__ __forceinline__ void run_phase(int ph, LAS unsigned char* lds, int wave_s) {
    const Args a = opaque_args();
#ifndef SKIP_P0
    if (ph == 0) { p0_phase(a, lds, wave_s); norm_phase(a, 0, wave_s); return; }
#endif
    const int l = (ph - 1) / 6, k = (ph - 1) % 6;
    pg8::StaticOrder S;
    if (k == 0) {
        pg8::Gemm g{(const h16*)(a.ws + WS_H), (const h16*)(a.ws + WS_WIN) + (size_t)l * NP * DM, R, NP, DM, nullptr, nullptr};
        S.init(R, NP, (int)gridDim.x, obid());
        EpiProj E{(h16*)(a.ws + WS_PROJ)};
#ifndef SKIP_G1
        pg8::gemm_phase(lds, g, S, E, wave_s);
#if PROBE_DOUBLE == 1
        pg8::gemm_phase(lds, g, S, E, wave_s);
#endif
#endif
    } else if (k == 1) {
#ifndef SKIP_PREP
        prep_phase(a, l, lds, wave_s);
#endif
    } else if (k == 2) {
#ifndef SKIP_ATTN
        attn_phase(a, l, lds, wave_s);
#if PROBE_DOUBLE == 2
        attn_phase(a, l, lds, wave_s);
#endif
#endif
    } else if (k == 3) {
        S.init(RM, DM, (int)gridDim.x, obid());
        { pg8::Gemm g{(const h16*)(a.ws + WS_AA), (const h16*)(a.ws + WS_WA) + (size_t)l * DM * 512, RM, DM, 512, (const h16*)(a.ws + WS_BB), (const h16*)(a.ws + WS_WB) + (size_t)l * DM * 512};
          EpiMerge2 E{(h16*)(a.ws + WS_H), (const h16*)(a.ws + WS_PROJ) + C_MG};
#ifndef SKIP_G2
          gemm_tail<1>(a, l, wave_s);
          pg8::gemm_phase<EpiMerge2, pg8::StaticOrder, true>(lds, g, S, E, wave_s);
#endif
        }
    } else if (k == 4) {
        S.init(RM, DM, (int)gridDim.x, obid());
        pg8::Gemm g{(const h16*)(a.ws + WS_H), (const h16*)(a.ws + WS_WO) + (size_t)l * DM * DM, RM, DM, DM, nullptr, nullptr};
        EpiResid E{l == 0 ? a.x : a.out, l == 0 ? a.meta : (const float*)(a.ws + WS_META), l == 0 ? 0 : NMETA * DM, a.out, (float*)(a.ws + WS_META)};
#ifndef SKIP_G3
        gemm_tail<2>(a, l, wave_s);
        pg8::gemm_phase(lds, g, S, E, wave_s);
#endif
    } else {
        norm_phase(a, l + 1, wave_s);
    }
}
constexpr int N_PHASES = 1 + 6 * DEPTH - 1;

__global__ __launch_bounds__(512, 2) void mega_fwd(Args a) {
    extern __shared__ __attribute__((aligned(16))) unsigned char shm[];
    LAS unsigned char* lds = (LAS unsigned char*)shm;
    cg::grid_group grid = cg::this_grid();
    int wave_s = __builtin_amdgcn_readfirstlane((int)threadIdx.x >> 6); asm volatile("" : "+s"(wave_s));
    volatile LAS unsigned* st = (volatile LAS unsigned*)(lds + L_BARST);
    if (threadIdx.x == 0) { st[0] = 0u; st[1] = 0u; }
    __syncthreads();
    const XcdBarrier xb = xcd_barrier_post((unsigned*)(a.ws + WS_BAR), st);
    for (int ph = a.ph_lo; ph < a.ph_hi; ++ph) {
        run_phase(ph, lds, wave_s);
        if (ph + 1 < a.ph_hi) { if (a.ph_lo < 0) grid.sync(); else xcd_barrier(xb, wave_s); }
    }
}

extern "C" void kernel_launch(void* const* d_in, const int* in_sizes, int n_in, void* d_out, int out_size, void* d_ws, size_t ws_size, hipStream_t stream) {
    static int grid = 0;
    if (grid == 0) {
        if (n_in != 12 || ws_size < WS_END) { fprintf(stderr, "kernel_launch: unexpected n_in %d / ws %zu (need %zu)\n", n_in, ws_size, (size_t)WS_END); grid = -1; return; }
        int dev = 0, cus = 0, per_cu = 0;
        hipGetDevice(&dev);
        hipDeviceGetAttribute(&cus, hipDeviceAttributeMultiprocessorCount, dev);
        if (hipFuncSetAttribute((const void*)mega_fwd, hipFuncAttributeMaxDynamicSharedMemorySize, LDS_BYTES) != hipSuccess) { fprintf(stderr, "kernel_launch: hipFuncSetAttribute failed\n"); grid = -1; return; }
        if (hipOccupancyMaxActiveBlocksPerMultiprocessor(&per_cu, (const void*)mega_fwd, 512, LDS_BYTES) != hipSuccess || per_cu < 1) { fprintf(stderr, "kernel_launch: occupancy query says %d\n", per_cu); per_cu = 1; }
        (void)hipGetLastError();
        grid = cus * 1;
    }
    if (grid < 0) return;
    (void)hipMemsetAsync((unsigned char*)d_ws + WS_BAR, 0, 32768, stream);
    Args a{};
    a.x = (const float*)d_in[0]; a.meta = (const float*)d_in[1]; a.norm_g = (const float*)d_in[2]; a.w_in = (const float*)d_in[3];
    a.qn_g = (const float*)d_in[4]; a.kn_g = (const float*)d_in[5]; a.pool_w = (const float*)d_in[6]; a.pool_b = (const float*)d_in[7];
    a.pool_s = (const float*)d_in[8]; a.w_a = (const float*)d_in[9]; a.w_b = (const float*)d_in[10]; a.w_out = (const float*)d_in[11];
    a.out = (float*)d_out; a.ws = (unsigned char*)d_ws;
#if PER_PHASE_LAUNCH
    for (int ph = 0; ph < N_PHASES; ++ph) {
        a.ph_lo = ph; a.ph_hi = ph + 1;
        hipLaunchKernelGGL(mega_fwd, dim3(grid), dim3(512), LDS_BYTES, stream, a);
    }
#else
    a.ph_lo = 0; a.ph_hi = N_PHASES;
    void* args[] = {&a};
    hipError_t e = hipLaunchCooperativeKernel((const void*)mega_fwd, dim3(grid), dim3(512), args, LDS_BYTES, stream);
    if (e != hipSuccess) fprintf(stderr, "cooperative launch failed: %s (grid %d)\n", hipGetErrorString(e), grid);
#endif
}
```

```cpp
#include <hip/hip_runtime.h>
#include <hip/hip_cooperative_groups.h>
#include <cstdio>
#include <cstdint>
namespace cg = cooperative_groups;

#ifndef PROBE_DOUBLE
#define PROBE_DOUBLE 0
#endif
#ifndef PER_PHASE_LAUNCH
#define PER_PHASE_LAUNCH 0
#endif

#define LAS __attribute__((address_space(3)))
#define GAS __attribute__((address_space(1)))
typedef _Float16 h16;
typedef _Float16 h16x8 __attribute__((ext_vector_type(8)));
typedef _Float16 h16x4 __attribute__((ext_vector_type(4)));
typedef _Float16 h16x2 __attribute__((ext_vector_type(2)));
typedef __fp16 fp16x4 __attribute__((__vector_size__(4 * sizeof(__fp16))));
typedef float f32x2 __attribute__((ext_vector_type(2)));
typedef float f32x4 __attribute__((ext_vector_type(4)));
typedef float f32x16 __attribute__((ext_vector_type(16)));
typedef unsigned u32x4 __attribute__((ext_vector_type(4)));
typedef unsigned u32x2 __attribute__((ext_vector_type(2)));

constexpr int NB = 16, SEQ = 4096, NMETA = 16, T = 4112, DM = 1024, DEPTH = 4, R = NB * T;
constexpr int DIN = 4808, NP = 4864;
constexpr int C_Q = 0, C_GA = 512, C_UB = 1024, C_GB = 1536, C_QI = 2048, C_MG = 2560, C_K = 4608, C_V = 4672, C_KI = 4736, C_WI = 4800;
constexpr float EPS = 1e-6f;

constexpr size_t WS_WIN = 0;
constexpr size_t WS_WA = WS_WIN + (size_t)DEPTH * NP * DM * 2;
constexpr size_t WS_WB = WS_WA + (size_t)DEPTH * DM * 512 * 2;
constexpr size_t WS_WO = WS_WB + (size_t)DEPTH * DM * 512 * 2;
constexpr size_t WS_WP = WS_WO + (size_t)DEPTH * DM * DM * 2;
constexpr size_t WS_ROPE = WS_WP + (size_t)DEPTH * 4 * 128 * 128 * 2;
constexpr size_t WS_META = WS_ROPE + (size_t)T * 32 * 8;
constexpr size_t WS_H = WS_META + (size_t)NB * NMETA * DM * 4;
constexpr size_t WS_PROJ = WS_H + (size_t)R * DM * 2;
constexpr size_t WS_AA = WS_PROJ + (size_t)R * NP * 2 + 65536;
constexpr size_t WS_BB = WS_AA + (size_t)R * 512 * 2;
constexpr size_t WS_KC = WS_BB + (size_t)R * 512 * 2;
constexpr size_t WS_VC = WS_KC + (size_t)(R + 64) * 128;
constexpr size_t WS_KIC = WS_VC + (size_t)(R + 64) * 128;
constexpr size_t WS_BAR = WS_KIC + (size_t)(R + 64) * 128;
constexpr size_t WS_END = WS_BAR + 32768;

constexpr int SCW = 4128;
constexpr int L_SC = 0;
constexpr int L_HQ = 8 * SCW * 4;
constexpr int L_SEL = L_HQ + 16384;
constexpr int L_MM = L_SEL + 4096;
constexpr int L_BARST = L_SEL + 4096 + 512;
constexpr int L_QA = L_SEL + 4096 + 1024;
constexpr int LDS_BYTES = L_QA + 8192;

struct Args {
    const float* x; const float* meta; const float* norm_g; const float* w_in; const float* qn_g; const float* kn_g;
    const float* pool_w; const float* pool_b; const float* pool_s; const float* w_a; const float* w_b; const float* w_out;
    float* out; unsigned char* ws; int ph_lo, ph_hi;
};

typedef __attribute__((address_space(4))) const unsigned char* kargp_t;
__device__ __forceinline__ Args opaque_args() {
#if defined(__HIP_DEVICE_COMPILE__)
    kargp_t kp = (kargp_t)__builtin_amdgcn_kernarg_segment_ptr();
    unsigned off; asm volatile("s_mov_b32 %0, 0" : "=s"(off));
    const __attribute__((address_space(4))) unsigned long long* p = (const __attribute__((address_space(4))) unsigned long long*)(kp + off);
    Args a;
    a.x = (const float*)(const GAS float*)p[0]; a.meta = (const float*)(const GAS float*)p[1]; a.norm_g = (const float*)(const GAS float*)p[2]; a.w_in = (const float*)(const GAS float*)p[3];
    a.qn_g = (const float*)(const GAS float*)p[4]; a.kn_g = (const float*)(const GAS float*)p[5]; a.pool_w = (const float*)(const GAS float*)p[6]; a.pool_b = (const float*)(const GAS float*)p[7];
    a.pool_s = (const float*)(const GAS float*)p[8]; a.w_a = (const float*)(const GAS float*)p[9]; a.w_b = (const float*)(const GAS float*)p[10]; a.w_out = (const float*)(const GAS float*)p[11];
    a.out = (float*)(GAS float*)p[12]; a.ws = (unsigned char*)(GAS unsigned char*)p[13]; a.ph_lo = 0; a.ph_hi = 0;
    return a;
#else
    return Args{};
#endif
}
__device__ __forceinline__ int olane() { int l = (int)__builtin_amdgcn_mbcnt_hi(~0u, __builtin_amdgcn_mbcnt_lo(~0u, 0u)); asm volatile("" : "+v"(l)); return l; }
__device__ __forceinline__ int otid(int wave_s) { return wave_s * 64 + olane(); }
__device__ __forceinline__ int obid() { int b = (int)blockIdx.x; asm volatile("" : "+s"(b)); return b; }
__device__ __forceinline__ unsigned pk2h(float a, float b) { h16x2 v; v.x = (h16)a; v.y = (h16)b; return __builtin_bit_cast(unsigned, v); }
__device__ __forceinline__ float wave_sum(float v) {
#pragma unroll
    for (int o = 1; o < 64; o <<= 1) v += __shfl_xor(v, o);
    return v;
}
__device__ __forceinline__ float fsigmoid(float x) { return __builtin_amdgcn_rcpf(1.0f + __expf(-x)); }
#define LDS_FENCE() asm volatile("s_waitcnt lgkmcnt(0)" ::: "memory")
#define LDS_ORDER() asm volatile("" ::: "memory")

namespace pg8 {
constexpr int BM = 256, BK = 64, HALF = 128, HTB = HALF * BK * 2, STAGE_BYTES = 8 * HTB, NXCD = 8, WGM = 8;
__device__ __forceinline__ int lds_byte(int r, int c) { const int st = (r >> 4) * 2 + (c >> 5), rr = r & 15, cc = c & 31, ob = rr * 64 + cc * 2; return st * 1024 + (ob ^ (((ob >> 9) & 1) << 5)); }
__device__ __forceinline__ void stage_rc(int b, int& Rr, int& C) { const int st = b / 1024, sb = b % 1024, swz = sb ^ (((sb >> 9) & 1) << 5); Rr = (st >> 1) * 16 + swz / 64; C = (st & 1) * 32 + (swz % 64) / 2; }
__device__ __forceinline__ int perm32(int rho) { const int n = rho >> 4, i = rho & 15; return 8 * (i >> 2) + 4 * n + (i & 3); }
struct Unit { int pm, pn; };
struct Gemm { const h16* A; const h16* Bt; int M, N, K; const h16* A2; const h16* Bt2; };
struct StaticOrder {
    int nM, nN, nwg, G, c;
    __device__ void init(int M, int N, int G_, int c_) { nM = M / BM; nN = N / BM; nwg = nM * nN; G = G_; c = c_; }
    __device__ bool next(int i, Unit& u) const {
        const long L = (long)i * G + c; if (L >= nwg) return false;
        int wgid = (int)L; { const int q = nwg / NXCD, r = nwg % NXCD, xcd = wgid % NXCD, off = wgid / NXCD; wgid = (xcd < r ? xcd * (q + 1) : r * (q + 1) + (xcd - r) * q) + off; }
        const int nig = WGM * nN, gid = wgid / nig, fm = gid * WGM, gsz = (nM - fm) < WGM ? (nM - fm) : WGM;
        u.pm = fm + ((wgid % nig) % gsz); u.pn = (wgid % nig) / gsz; return true;
    }
};

template <class Epi, class Sched, bool DUAL = false>
__device__ __forceinline__ void gemm_phase(LAS unsigned char* lds, const Gemm g, const Sched& S, const Epi& E, int wave_s) {
    const int tid = otid(wave_s), wid = __builtin_amdgcn_readfirstlane(tid >> 6), lane = tid & 63, wr = wid >> 2, wc = wid & 3, fr = lane & 15, fq = lane >> 4;
    const int K = g.K, nt = K / BK;
    unsigned voffA[2], voffB0[2], voffB1[2];
#pragma unroll
    for (int i = 0; i < 2; ++i) { int Rr, C; stage_rc(tid * 16 + i * 8192, Rr, C); const int pr = Epi::PERM ? perm32(Rr & 31) : (Rr & 31); const int Rb = (Rr >> 5) * 64 + pr;
        voffA[i] = (unsigned)(Rr * K + C) * 2u; voffB0[i] = (unsigned)(Rb * K + C) * 2u; voffB1[i] = (unsigned)((Rb + 32) * K + C) * 2u; }
    const size_t kstep = (size_t)(BK * 2);
    const size_t hstep = (size_t)HALF * K * 2;
    const size_t tstep = 2 * hstep;
    const unsigned ldsw = (unsigned)wid * 1024u;
    const int aoff = lds_byte(wr * 64 + fr, fq * 8), boff = lds_byte(wc * 32 + fr, fq * 8);
#define PG8_SA(b, h) (((b) * 2 + (h)) * HTB)
#define PG8_SB(b, h) ((4 + (b) * 2 + (h)) * HTB)
#define PG8_STAGE(bufoff, gbase, voff) do { _Pragma("unroll") for (int _i = 0; _i < 2; ++_i) \
        __builtin_amdgcn_global_load_lds((const unsigned*)((const char*)(gbase) + (voff)[_i]), (LAS unsigned*)(lds + (bufoff) + ldsw + _i * 8192), 16, 0, 0); } while (0)
#define PG8_LDA(dst, b, h) do { _Pragma("unroll") for (int m = 0; m < 4; ++m) _Pragma("unroll") for (int k = 0; k < 2; ++k) dst[m][k] = *(const LAS h16x8*)(lds + PG8_SA(b, h) + aoff + m * 2048 + k * 1024); } while (0)
#define PG8_LDB(dst, b, h) do { _Pragma("unroll") for (int n = 0; n < 2; ++n) _Pragma("unroll") for (int k = 0; k < 2; ++k) dst[n][k] = *(const LAS h16x8*)(lds + PG8_SB(b, h) + boff + n * 2048 + k * 1024); } while (0)
#define PG8_MMA(ai, bj, At, Bt) do { __builtin_amdgcn_s_setprio(1); _Pragma("unroll") for (int m = 0; m < 4; ++m) _Pragma("unroll") for (int n = 0; n < 2; ++n) _Pragma("unroll") for (int k = 0; k < 2; ++k) \
        acc[ai][bj][m][n] = __builtin_amdgcn_mfma_f32_16x16x32_f16(Bt[n][k], At[m][k], acc[ai][bj][m][n], 0, 0, 0); __builtin_amdgcn_s_setprio(0); } while (0)
#define PG8_WAIT_V(n) asm volatile("s_waitcnt vmcnt(" #n ")" ::: "memory")
#define PG8_WAIT_L(n) asm volatile("s_waitcnt lgkmcnt(" #n ")" ::: "memory")
#define PG8_BAR __builtin_amdgcn_s_barrier()
#define PG8_SCHED __builtin_amdgcn_sched_barrier(0)
    Unit cur, nxt; int ui = 0;
    if (!S.next(0, cur)) return;
    f32x4 acc[2][2][4][2];
#pragma unroll
    for (int a = 0; a < 2; ++a)
#pragma unroll
        for (int b = 0; b < 2; ++b)
#pragma unroll
            for (int m = 0; m < 4; ++m)
#pragma unroll
                for (int n = 0; n < 2; ++n) acc[a][b][m][n] = (f32x4){0.f, 0.f, 0.f, 0.f};
    h16x8 At[4][2], B0[2][2], B1[2][2];
    const char* cA = (const char*)g.A + (size_t)cur.pm * tstep; const char* cB = (const char*)g.Bt + (size_t)cur.pn * tstep;
    PG8_STAGE(PG8_SB(0, 0), cB, voffB0); PG8_STAGE(PG8_SA(0, 0), cA, voffA); PG8_STAGE(PG8_SB(0, 1), cB, voffB1); PG8_STAGE(PG8_SA(0, 1), cA + hstep, voffA);
    if (wr == 1) PG8_BAR;
    PG8_WAIT_V(4); PG8_BAR;
    PG8_STAGE(PG8_SB(1, 0), cB + kstep, voffB0); PG8_STAGE(PG8_SA(1, 0), cA + kstep, voffA); PG8_STAGE(PG8_SB(1, 1), cB + kstep, voffB1);
    PG8_WAIT_V(6); PG8_BAR;
#define PG8_KLOOP(cA_, cB_, nA_, nB_) do { \
        for (int t = 0; t < nt; t += 2) { \
            const bool last = (t == nt - 2); \
            const char* a1 = (cA_) + (size_t)(t + 1) * kstep; \
            const char* a2 = last ? (nA_) : (cA_) + (size_t)(t + 2) * kstep; const char* b2 = last ? (nB_) : (cB_) + (size_t)(t + 2) * kstep; \
            const char* a3 = a2 + kstep; const char* b3 = b2 + kstep; \
            PG8_LDB(B0, 0, 0); PG8_SCHED; PG8_LDA(At, 0, 0); PG8_STAGE(PG8_SA(1, 1), a1 + hstep, voffA); \
            PG8_WAIT_L(8); PG8_BAR; PG8_WAIT_L(0); PG8_MMA(0, 0, At, B0); PG8_BAR; PG8_SCHED; \
            PG8_LDB(B1, 0, 1); PG8_STAGE(PG8_SB(0, 0), b2, voffB0); \
            PG8_BAR; PG8_WAIT_L(0); PG8_MMA(0, 1, At, B1); PG8_BAR; \
            PG8_LDA(At, 0, 1); PG8_STAGE(PG8_SA(0, 0), a2, voffA); \
            PG8_BAR; PG8_WAIT_L(0); PG8_MMA(1, 0, At, B0); PG8_BAR; PG8_SCHED; \
            PG8_STAGE(PG8_SB(0, 1), b2, voffB1); \
            PG8_WAIT_V(6); PG8_BAR; PG8_MMA(1, 1, At, B1); PG8_BAR; \
            PG8_LDB(B0, 1, 0); PG8_SCHED; PG8_LDA(At, 1, 0); PG8_STAGE(PG8_SA(0, 1), a2 + hstep, voffA); \
            PG8_WAIT_L(8); PG8_BAR; PG8_WAIT_L(0); PG8_MMA(0, 0, At, B0); PG8_BAR; PG8_SCHED; \
            PG8_LDB(B1, 1, 1); PG8_STAGE(PG8_SB(1, 0), b3, voffB0); \
            PG8_BAR; PG8_WAIT_L(0); PG8_MMA(0, 1, At, B1); PG8_BAR; \
            PG8_LDA(At, 1, 1); PG8_STAGE(PG8_SA(1, 0), a3, voffA); \
            PG8_BAR; PG8_WAIT_L(0); PG8_MMA(1, 0, At, B0); PG8_BAR; PG8_SCHED; \
            PG8_STAGE(PG8_SB(1, 1), b3, voffB1); \
            PG8_WAIT_V(6); PG8_BAR; PG8_MMA(1, 1, At, B1); PG8_BAR; \
        } \
    } while (0)
    for (;;) {
        if constexpr (DUAL) {
            const char* mA = (const char*)g.A2 + (size_t)cur.pm * tstep; const char* mB = (const char*)g.Bt2 + (size_t)cur.pn * tstep;
            PG8_KLOOP(cA, cB, mA, mB);
            E.mid(acc, cur, wr, wc, fr, fq, lds + 131072 + wid * 2048);
            cA = mA; cB = mB;
        }
        const bool has_next = S.next(ui + 1, nxt);
        const char* nA = has_next ? (const char*)g.A + (size_t)nxt.pm * tstep : cA; const char* nB = has_next ? (const char*)g.Bt + (size_t)nxt.pn * tstep : cB;
        PG8_KLOOP(cA, cB, nA, nB);
        E(acc, cur, wr, wc, fr, fq, lds + 131072 + wid * 2048);
        if (!has_next) break;
#pragma unroll
        for (int a = 0; a < 2; ++a)
#pragma unroll
            for (int b = 0; b < 2; ++b)
#pragma unroll
                for (int m = 0; m < 4; ++m)
#pragma unroll
                    for (int n = 0; n < 2; ++n) acc[a][b][m][n] = (f32x4){0.f, 0.f, 0.f, 0.f};
        cur = nxt; cA = nA; cB = nB; ++ui;
    }
    PG8_WAIT_V(0);
    if (wr == 0) PG8_BAR;
    PG8_BAR;
#undef PG8_KLOOP
#undef PG8_SA
#undef PG8_SB
#undef PG8_STAGE
#undef PG8_LDA
#undef PG8_LDB
#undef PG8_MMA
#undef PG8_WAIT_V
#undef PG8_WAIT_L
#undef PG8_BAR
#undef PG8_SCHED
}
}

__device__ __forceinline__ const float* xrow_src(const Args& a, int l, int row) {
    const int b = row / T, t = row - b * T;
    if (l == 0) return t < NMETA ? a.meta + (size_t)t * DM : a.x + ((size_t)b * SEQ + (t - NMETA)) * DM;
    return t < NMETA ? (const float*)(a.ws + WS_META) + ((size_t)b * NMETA + t) * DM : a.out + ((size_t)b * SEQ + (t - NMETA)) * DM;
}
__device__ __forceinline__ float* xrow_dst(const Args& a, int row) {
    const int b = row / T, t = row - b * T;
    return t < NMETA ? (float*)(a.ws + WS_META) + ((size_t)b * NMETA + t) * DM : a.out + ((size_t)b * SEQ + (t - NMETA)) * DM;
}

__device__ __forceinline__ int xoff(int row, int piece) { return row * 128 + ((piece ^ (row & 7)) * 16); }
struct EpiProj {
    static constexpr bool PERM = true;
    h16* O;
    __device__ __forceinline__ void operator()(const f32x4 (&acc)[2][2][4][2], const pg8::Unit& u, int wr, int wc, int fr, int fq, LAS unsigned char* xl) const {
        int row0 = u.pm * 256 + wr * 64, col0 = u.pn * 256 + wc * 64;
        asm volatile("" : "+s"(row0), "+s"(col0));
        const int ln = fq * 16 + fr, rr = ln >> 3, pp = ln & 7;
        const int pn = u.pn;
        const int act = (pn == 2 || pn == 3 || pn == 6 || pn == 7) ? 1 : ((pn >= 10 && pn < 18) ? 2 : 0);
#pragma unroll
        for (int ai = 0; ai < 2; ++ai)
#pragma unroll
            for (int m = 0; m < 4; ++m) {
#pragma unroll
                for (int bj = 0; bj < 2; ++bj) { f32x4 v0 = acc[ai][bj][m][0], v1 = acc[ai][bj][m][1];
                    if (act) {
#pragma unroll
                        for (int e = 0; e < 4; ++e) { const float s0 = fsigmoid(v0[e]), s1 = fsigmoid(v1[e]); v0[e] = act == 1 ? v0[e] * s0 : s0; v1[e] = act == 1 ? v1[e] * s1 : s1; }
                    }
                    u32x4 o; o.x = pk2h(v0[0], v0[1]); o.y = pk2h(v0[2], v0[3]); o.z = pk2h(v1[0], v1[1]); o.w = pk2h(v1[2], v1[3]);
                    *(LAS u32x4*)(xl + xoff(fr, bj * 4 + fq)) = o; }
                LDS_FENCE();
                const u32x4 t0 = *(const LAS u32x4*)(xl + xoff(rr, pp)), t1 = *(const LAS u32x4*)(xl + xoff(rr + 8, pp));
                h16* rowp = O + (size_t)(row0 + ai * 128 + m * 16 + rr) * NP + col0 + pp * 8;
                *(u32x4*)rowp = t0; *(u32x4*)(rowp + (size_t)8 * NP) = t1;
                LDS_ORDER();
            }
    }
};
__device__ __forceinline__ float gsig(float mb) { return fmaxf(fsigmoid(mb), 6.1035e-5f); }
struct EpiMerge2 {
    static constexpr bool PERM = true;
    h16* O; const h16* G;
    __device__ __forceinline__ void mid(f32x4 (&acc)[2][2][4][2], const pg8::Unit& u, int wr, int wc, int fr, int fq, LAS unsigned char* xl) const {
        int row0 = u.pm * 256 + wr * 64, col0 = u.pn * 256 + wc * 64;
        asm volatile("" : "+s"(row0), "+s"(col0));
        const int ln = fq * 16 + fr, rr = ln >> 3, pp = ln & 7;
#pragma unroll
        for (int aim = 0; aim < 4; ++aim) { const int ai = aim >> 1, mb = (aim & 1) * 2;
            h16x8 ga[4][2], gb[4][2];
#pragma unroll
            for (int m = mb; m < mb + 2; ++m) { const h16* gp = G + (size_t)(row0 + ai * 128 + m * 16 + rr) * NP + col0 + pp * 8;
                ga[m][0] = *(const h16x8*)gp; gb[m][0] = *(const h16x8*)(gp + 1024); ga[m][1] = *(const h16x8*)(gp + (size_t)8 * NP); gb[m][1] = *(const h16x8*)(gp + (size_t)8 * NP + 1024); }
            __builtin_amdgcn_sched_barrier(0);
#pragma unroll
            for (int m = mb; m < mb + 2; ++m) {
                h16x8 r0, r1;
#pragma unroll
                for (int e = 0; e < 8; ++e) { r0[e] = (h16)((float)ga[m][0][e] * __builtin_amdgcn_rcpf(fmaxf((float)gb[m][0][e], 6.1035e-5f))); r1[e] = (h16)((float)ga[m][1][e] * __builtin_amdgcn_rcpf(fmaxf((float)gb[m][1][e], 6.1035e-5f))); }
                *(LAS h16x8*)(xl + xoff(rr, pp)) = r0; *(LAS h16x8*)(xl + xoff(rr + 8, pp)) = r1;
                LDS_FENCE();
#pragma unroll
                for (int bj = 0; bj < 2; ++bj) { const h16x8 rt = *(const LAS h16x8*)(xl + xoff(fr, bj * 4 + fq));
#pragma unroll
                    for (int e = 0; e < 4; ++e) { const float f0 = (float)rt[e], f1 = (float)rt[4 + e];
                        asm volatile("v_mul_f32 %0, %0, %1" : "+v"(acc[ai][bj][m][0][e]) : "v"(f0)); asm volatile("v_mul_f32 %0, %0, %1" : "+v"(acc[ai][bj][m][1][e]) : "v"(f1)); } }
                LDS_ORDER();
            }
        }
    }
    __device__ __forceinline__ void operator()(const f32x4 (&acc)[2][2][4][2], const pg8::Unit& u, int wr, int wc, int fr, int fq, LAS unsigned char* xl) const {
        int row0 = u.pm * 256 + wr * 64, col0 = u.pn * 256 + wc * 64;
        asm volatile("" : "+s"(row0), "+s"(col0));
        const int ln = fq * 16 + fr, rr = ln >> 3, pp = ln & 7;
#pragma unroll
        for (int ai = 0; ai < 2; ++ai) {
            h16x8 gb[2][4][2];
#pragma unroll
            for (int m = 0; m < 4; ++m) { const h16* gp = G + (size_t)(row0 + ai * 128 + m * 16 + rr) * NP + col0 + pp * 8 + 1024;
                gb[ai][m][0] = *(const h16x8*)gp; gb[ai][m][1] = *(const h16x8*)(gp + (size_t)8 * NP); }
            __builtin_amdgcn_sched_barrier(0);
#pragma unroll
            for (int m = 0; m < 4; ++m) {
#pragma unroll
                for (int bj = 0; bj < 2; ++bj) { const f32x4 v0 = acc[ai][bj][m][0], v1 = acc[ai][bj][m][1];
                    u32x4 o; o.x = pk2h(v0[0], v0[1]); o.y = pk2h(v0[2], v0[3]); o.z = pk2h(v1[0], v1[1]); o.w = pk2h(v1[2], v1[3]);
                    *(LAS u32x4*)(xl + xoff(fr, bj * 4 + fq)) = o; }
                LDS_FENCE();
                const h16x8 t0 = *(const LAS h16x8*)(xl + xoff(rr, pp)), t1 = *(const LAS h16x8*)(xl + xoff(rr + 8, pp));
                float q0[8], q1[8];
#pragma unroll
                for (int e = 0; e < 8; ++e) { q0[e] = (float)t0[e] * fmaxf((float)gb[ai][m][0][e], 6.1035e-5f); q1[e] = (float)t1[e] * fmaxf((float)gb[ai][m][1][e], 6.1035e-5f); }
                u32x4 o0, o1; o0.x = pk2h(q0[0], q0[1]); o0.y = pk2h(q0[2], q0[3]); o0.z = pk2h(q0[4], q0[5]); o0.w = pk2h(q0[6], q0[7]);
                o1.x = pk2h(q1[0], q1[1]); o1.y = pk2h(q1[2], q1[3]); o1.z = pk2h(q1[4], q1[5]); o1.w = pk2h(q1[6], q1[7]);
                h16* rowp = O + (size_t)(row0 + ai * 128 + m * 16 + rr) * DM + col0 + pp * 8;
                *(u32x4*)rowp = o0; *(u32x4*)(rowp + (size_t)8 * DM) = o1;
                LDS_ORDER();
            }
        }
    }
};
struct EpiResid {
    static constexpr bool PERM = false;
    const float* s_real; const float* s_meta; int s_meta_bstride; float* d_real; float* d_meta;
    __device__ __forceinline__ void operator()(const f32x4 (&acc)[2][2][4][2], const pg8::Unit& u, int wr, int wc, int fr, int fq, LAS unsigned char* xl) const {
        int row0 = u.pm * 256 + wr * 64, col0 = u.pn * 256 + wc * 64;
        asm volatile("" : "+s"(row0), "+s"(col0));
        const int ln = fq * 16 + fr, rr = ln >> 3, pp = ln & 7;
#pragma unroll
        for (int aim = 0; aim < 4; ++aim) { const int ai = aim >> 1, mb = (aim & 1) * 2;
            f32x4 xo[4][2][2];
#pragma unroll
            for (int m = mb; m < mb + 2; ++m)
#pragma unroll
                for (int h = 0; h < 2; ++h) { const int row = row0 + ai * 128 + m * 16 + rr + 8 * h; const int b = row / T, t = row - b * T;
                    const float* sp = (t < NMETA ? s_meta + (size_t)b * s_meta_bstride + (size_t)t * DM : s_real + ((size_t)b * SEQ + (t - NMETA)) * DM) + col0 + pp * 4;
                    xo[m][h][0] = *(const f32x4*)sp; xo[m][h][1] = *(const f32x4*)(sp + 32); }
            __builtin_amdgcn_sched_barrier(0);
#pragma unroll
            for (int m = mb; m < mb + 2; ++m) {
                float* dp[2];
#pragma unroll
                for (int h = 0; h < 2; ++h) { const int row = row0 + ai * 128 + m * 16 + rr + 8 * h; const int b = row / T, t = row - b * T;
                    dp[h] = (t < NMETA ? d_meta + ((size_t)b * NMETA + t) * DM : d_real + ((size_t)b * SEQ + (t - NMETA)) * DM) + col0 + pp * 4; }
#pragma unroll
                for (int bj = 0; bj < 2; ++bj) {
                    *(LAS f32x4*)(xl + xoff(fr, fq)) = acc[ai][bj][m][0]; *(LAS f32x4*)(xl + xoff(fr, 4 + fq)) = acc[ai][bj][m][1];
                    LDS_FENCE();
                    const f32x4 t0 = *(const LAS f32x4*)(xl + xoff(rr, pp)), t1 = *(const LAS f32x4*)(xl + xoff(rr + 8, pp));
                    *(f32x4*)(dp[0] + bj * 32) = xo[m][0][bj] + t0; *(f32x4*)(dp[1] + bj * 32) = xo[m][1][bj] + t1;
                    LDS_ORDER();
                }
            }
        }
    }
};

constexpr int RM = R - 256;
template <int MODE>
__device__ __forceinline__ void gemm_tail(const Args& a, int l, int wave_s) {
    const int tid = otid(wave_s), bid = obid(), wave = tid >> 6, lane = tid & 63, fr = lane & 15, fq = lane >> 4;
    const int gw = wave * (int)gridDim.x + bid, NGW = (int)gridDim.x * 8;
    constexpr int N = MODE == 0 ? NP : DM, K = MODE == 1 ? 512 : DM, NSEG = MODE == 1 ? 2 : 1;
    const h16* PROJ = (const h16*)(a.ws + WS_PROJ);
    for (int task = gw; task < 8 * (N / 16); task += NGW) {
        const int row0 = RM + (task & 7) * 32, col0 = (task >> 3) * 16;
        f32x4 acc[2];
#pragma unroll
        for (int mt = 0; mt < 2; ++mt) acc[mt] = (f32x4){0.f, 0.f, 0.f, 0.f};
#pragma unroll
        for (int seg = 0; seg < NSEG; ++seg) {
            const h16* A = MODE == 1 ? (const h16*)(a.ws + (seg ? WS_BB : WS_AA)) : (const h16*)(a.ws + WS_H);
            const h16* Bt = MODE == 0 ? (const h16*)(a.ws + WS_WIN) + (size_t)l * NP * DM : MODE == 1 ? (const h16*)(a.ws + (seg ? WS_WB : WS_WA)) + (size_t)l * DM * 512 : (const h16*)(a.ws + WS_WO) + (size_t)l * DM * DM;
            const h16* ap = A + (size_t)(row0 + fr) * K + fq * 8;
            const h16* bp = Bt + (size_t)(col0 + fr) * K + fq * 8;
#pragma unroll 8
            for (int k = 0; k < K; k += 32) {
                const h16x8 bf = *(const h16x8*)(bp + k);
#pragma unroll
                for (int mt = 0; mt < 2; ++mt) { const h16x8 af = *(const h16x8*)(ap + (size_t)mt * 16 * K + k); acc[mt] = __builtin_amdgcn_mfma_f32_16x16x32_f16(bf, af, acc[mt], 0, 0, 0); }
            }
            if (MODE == 1 && seg == 0) {
#pragma unroll
                for (int mt = 0; mt < 2; ++mt) { const h16* gp = PROJ + (size_t)(row0 + 16 * mt + fr) * NP + C_MG + col0 + 4 * fq;
                    const h16x4 ga = *(const h16x4*)gp, gb = *(const h16x4*)(gp + 1024);
#pragma unroll
                    for (int j = 0; j < 4; ++j) acc[mt][j] *= (float)ga[j] * __builtin_amdgcn_rcpf(fmaxf((float)gb[j], 6.1035e-5f)); }
            }
        }
#pragma unroll
        for (int mt = 0; mt < 2; ++mt) { const int row = row0 + 16 * mt + fr, c = col0 + 4 * fq;
            if (MODE == 0) { const int pn = c >> 8; const int act = (pn == 2 || pn == 3 || pn == 6 || pn == 7) ? 1 : ((pn >= 10 && pn < 18) ? 2 : 0);
                float v[4];
#pragma unroll
                for (int j = 0; j < 4; ++j) { const float x = acc[mt][j], sg = fsigmoid(x); v[j] = act == 1 ? x * sg : (act == 2 ? sg : x); }
                u32x2 o; o.x = pk2h(v[0], v[1]); o.y = pk2h(v[2], v[3]);
                *(u32x2*)((h16*)(a.ws + WS_PROJ) + (size_t)row * NP + c) = o;
            } else if (MODE == 1) { const h16x4 gb = *(const h16x4*)(PROJ + (size_t)row * NP + C_MG + 1024 + c);
                u32x2 o; o.x = pk2h(acc[mt][0] * fmaxf((float)gb[0], 6.1035e-5f), acc[mt][1] * fmaxf((float)gb[1], 6.1035e-5f)); o.y = pk2h(acc[mt][2] * fmaxf((float)gb[2], 6.1035e-5f), acc[mt][3] * fmaxf((float)gb[3], 6.1035e-5f));
                *(u32x2*)((h16*)(a.ws + WS_H) + (size_t)row * DM + c) = o;
            } else { const f32x4 xo = *(const f32x4*)(xrow_src(a, l, row) + c); *(f32x4*)(xrow_dst(a, row) + c) = xo + acc[mt]; }
        }
    }
}

__device__ __forceinline__ void tr_item(const float* W, int ldw, int K, int k0, int srccol0, int nvalid, h16* WT, LAS float* scr, int lane) {
    {
        const int c4 = (lane & 7) * 4; f32x4 v[8];
#pragma unroll
        for (int j = 0; j < 8; ++j) { const int kk = (lane >> 3) + 8 * j; v[j] = (c4 < nvalid) ? *(const f32x4*)(W + (size_t)(k0 + kk) * ldw + srccol0 + c4) : (f32x4){0.f, 0.f, 0.f, 0.f}; }
#pragma unroll
        for (int j = 0; j < 8; ++j) { const int kk = (lane >> 3) + 8 * j;
#pragma unroll
            for (int e = 0; e < 4; ++e) scr[kk * 33 + c4 + e] = v[j][e]; }
    }
    LDS_FENCE();
    const int c8 = lane & 7;
#pragma unroll
    for (int j = 0; j < 4; ++j) { const int n = (lane >> 3) + 8 * j; const LAS float* s = scr + (8 * c8) * 33 + n;
        u32x4 o; o.x = pk2h(s[0 * 33], s[1 * 33]); o.y = pk2h(s[2 * 33], s[3 * 33]); o.z = pk2h(s[4 * 33], s[5 * 33]); o.w = pk2h(s[6 * 33], s[7 * 33]);
        *(u32x4*)(WT + (size_t)n * K + k0 + 8 * c8) = o; }
    LDS_FENCE();
}
__device__ __forceinline__ void win_srcmap(int n0, int& src, int& nvalid) {
    nvalid = 32;
    if (n0 < 512) src = n0;
    else if (n0 < 1024) src = 640 + (n0 - 512);
    else if (n0 < 1536) src = 1152 + (n0 - 1024);
    else if (n0 < 2048) src = 1664 + (n0 - 1536);
    else if (n0 < 2560) src = 2176 + (n0 - 2048);
    else if (n0 < 4608) src = 2760 + (n0 - 2560);
    else if (n0 < 4672) src = 512 + (n0 - 4608);
    else if (n0 < 4736) src = 576 + (n0 - 4672);
    else if (n0 < 4800) src = 2688 + (n0 - 4736);
    else if (n0 == 4800) { src = 2752; nvalid = 8; }
    else { src = 0; nvalid = 0; }
}
__device__ __forceinline__ void p0_phase(const Args& a, LAS unsigned char* lds, int wave_s) {
    const int tid0 = otid(wave_s), bid = obid();
    const int wave = tid0 >> 6, lane = tid0 & 63;
    LAS float* scr = (LAS float*)(lds + wave * 16384);
    const int gw = bid * 8 + wave, NGW = gridDim.x * 8;
    constexpr int I_IN = 16 * (NP / 32), I_A = 8 * 32, I_O = 16 * 32, I_P = 4 * 2 * 4, I_L = I_IN + 2 * I_A + I_O + I_P;
    for (int it = gw; it < DEPTH * I_L; it += NGW) {
        const int l = it / I_L; int r = it - l * I_L;
        if (r < I_IN) { const int kb = r / (NP / 32), nb = r % (NP / 32); int src, nv; win_srcmap(nb * 32, src, nv);
            tr_item(a.w_in + (size_t)l * DM * DIN, DIN, DM, kb * 64, src, nv, (h16*)(a.ws + WS_WIN) + ((size_t)l * NP + nb * 32) * DM, scr, lane); continue; }
        r -= I_IN;
        if (r < I_A) { const int kb = r / 32, nb = r % 32;
            tr_item(a.w_a + (size_t)l * 512 * DM, DM, 512, kb * 64, nb * 32, 32, (h16*)(a.ws + WS_WA) + ((size_t)l * DM + nb * 32) * 512, scr, lane); continue; }
        r -= I_A;
        if (r < I_A) { const int kb = r / 32, nb = r % 32;
            tr_item(a.w_b + (size_t)l * 512 * DM, DM, 512, kb * 64, nb * 32, 32, (h16*)(a.ws + WS_WB) + ((size_t)l * DM + nb * 32) * 512, scr, lane); continue; }
        r -= I_A;
        if (r < I_O) { const int kb = r / 32, nb = r % 32;
            tr_item(a.w_out + (size_t)l * DM * DM, DM, DM, kb * 64, nb * 32, 32, (h16*)(a.ws + WS_WO) + ((size_t)l * DM + nb * 32) * DM, scr, lane); continue; }
        r -= I_O;
        { const int g = r / 8, q = r % 8, kb = q / 4, nb = q % 4;
            tr_item(a.pool_w + ((size_t)l * 4 + g) * 128 * 128, 128, 128, kb * 64, nb * 32, 32, (h16*)(a.ws + WS_WP) + (((size_t)l * 4 + g) * 128 + nb * 32) * 128, scr, lane); }
    }
    f32x2* cs = (f32x2*)(a.ws + WS_ROPE);
    for (int i = bid * 512 + tid0; i < T * 32; i += gridDim.x * 512) {
        const int t = i >> 5, j = i & 31;
        const float invf = 1.0f / powf(10000.0f, (float)(2 * j) / 64.0f);
        const float ang = (float)t * invf;
        const double rev = (double)ang * 0.15915494309189533577;
        const double fr = rev - __builtin_rint(rev);
        const float rf = (float)fr;
        f32x2 o; o.x = __builtin_amdgcn_cosf(rf); o.y = __builtin_amdgcn_sinf(rf);
        cs[i] = o;
    }
}

__device__ __forceinline__ void norm_phase(const Args& a, int l, int wave_s) {
    const int tid0 = otid(wave_s), bid = obid();
    const int wave = tid0 >> 6, lane = tid0 & 63;
    const int gw = bid * 8 + wave, NGW = gridDim.x * 8;
    const f32x4* gp = (const f32x4*)(a.norm_g + (size_t)l * DM) + lane;
    f32x4 gn[4];
#pragma unroll
    for (int j = 0; j < 4; ++j) gn[j] = gp[64 * j];
    h16* H = (h16*)(a.ws + WS_H);
    for (int row = gw; row < R; row += 2 * NGW) {
        const int row2 = row + NGW < R ? row + NGW : row;
        const f32x4* xr = (const f32x4*)xrow_src(a, l, row) + lane;
        const f32x4* xr2 = (const f32x4*)xrow_src(a, l, row2) + lane;
        f32x4 v[4], w[4]; float s = 0.f, s2 = 0.f;
#pragma unroll
        for (int j = 0; j < 4; ++j) { v[j] = xr[64 * j]; w[j] = xr2[64 * j]; }
#pragma unroll
        for (int j = 0; j < 4; ++j) { s += (v[j].x * v[j].x + v[j].y * v[j].y) + (v[j].z * v[j].z + v[j].w * v[j].w); s2 += (w[j].x * w[j].x + w[j].y * w[j].y) + (w[j].z * w[j].z + w[j].w * w[j].w); }
        const float rs = 1.0f / sqrtf(wave_sum(s) * (1.0f / DM) + EPS), rs2 = 1.0f / sqrtf(wave_sum(s2) * (1.0f / DM) + EPS);
        u32x2* o8 = (u32x2*)(H + (size_t)row * DM) + lane; u32x2* o82 = (u32x2*)(H + (size_t)row2 * DM) + lane;
#pragma unroll
        for (int j = 0; j < 4; ++j) { u32x2 o; o.x = pk2h(v[j].x * rs * gn[j].x, v[j].y * rs * gn[j].y); o.y = pk2h(v[j].z * rs * gn[j].z, v[j].w * rs * gn[j].w); o8[64 * j] = o; }
        if (row2 != row) {
#pragma unroll
            for (int j = 0; j < 4; ++j) { u32x2 o; o.x = pk2h(w[j].x * rs2 * gn[j].x, w[j].y * rs2 * gn[j].y); o.y = pk2h(w[j].z * rs2 * gn[j].z, w[j].w * rs2 * gn[j].w); o82[64 * j] = o; }
        }
    }
}

template <int W>
__device__ __forceinline__ void pool_stage(const h16* up, int t, LAS h16* dst) {
    const int cnt = (t + 1 < W) ? (t + 1) : W;
    float sum[16], u0[16];
#pragma unroll
    for (int jj = 0; jj < W; ++jj) {
        const bool ok = jj < cnt;
        const h16* p = up - (size_t)(ok ? jj : 0) * NP;
        const h16x8 v0 = *(const h16x8*)p, v1 = *(const h16x8*)(p + 8);
        if (jj == 0) {
#pragma unroll
            for (int e = 0; e < 8; ++e) { u0[e] = (float)v0[e]; u0[8 + e] = (float)v1[e]; sum[e] = u0[e]; sum[8 + e] = u0[8 + e]; }
        } else {
#pragma unroll
            for (int e = 0; e < 8; ++e) { sum[e] += ok ? (float)v0[e] : 0.f; sum[8 + e] += ok ? (float)v1[e] : 0.f; }
        }
    }
    const float ic = 1.0f / (float)cnt;
    u32x4 o0, o1;
    o0.x = pk2h(sum[0] * ic - u0[0], sum[1] * ic - u0[1]); o0.y = pk2h(sum[2] * ic - u0[2], sum[3] * ic - u0[3]);
    o0.z = pk2h(sum[4] * ic - u0[4], sum[5] * ic - u0[5]); o0.w = pk2h(sum[6] * ic - u0[6], sum[7] * ic - u0[7]);
    o1.x = pk2h(sum[8] * ic - u0[8], sum[9] * ic - u0[9]); o1.y = pk2h(sum[10] * ic - u0[10], sum[11] * ic - u0[11]);
    o1.z = pk2h(sum[12] * ic - u0[12], sum[13] * ic - u0[13]); o1.w = pk2h(sum[14] * ic - u0[14], sum[15] * ic - u0[15]);
    *(LAS u32x4*)dst = o0; *(LAS u32x4*)(dst + 8) = o1;
}
template <int W>
__device__ __forceinline__ void pool_loop(const Args& a, int l, LAS unsigned char* lds, int tid, int w, int Gg, int wave, int lane) {
    constexpr int g = W == 2 ? 0 : W == 4 ? 1 : W == 8 ? 2 : 3;
    const h16* PROJ = (const h16*)(a.ws + WS_PROJ);
    h16* BB = (h16*)(a.ws + WS_BB);
    LAS h16* PT0 = (LAS h16*)lds;
    const int fr = lane & 15, fq = lane >> 4, tok = tid >> 3, cseg = tid & 7;
    const int NIT = (R / 64) * 4, step = 4 * Gg;
    const h16* wp = (const h16*)(a.ws + WS_WP) + (size_t)l * 4 * 128 * 128 + ((size_t)g * 128 + 16 * wave + fr) * 128 + 8 * fq;
    h16x8 wf[4];
#pragma unroll
    for (int kk = 0; kk < 4; ++kk) wf[kk] = *(const h16x8*)(wp + 32 * kk);
    const int col = g * 128 + 16 * wave + 4 * fq;
    const f32x4 pb = *(const f32x4*)(a.pool_b + l * 512 + col), ps = *(const f32x4*)(a.pool_s + l * 512 + col);
    constexpr int WP = W < 8 ? W : 8;
    h16x8 v[2 * WP];
#define POOL_LOAD(item_) do { const int _row = ((item_) >> 2) * 64 + tok, _t = _row % T; const int _cnt = (_t + 1 < W) ? (_t + 1) : W; \
        const h16* _up = PROJ + (size_t)_row * NP + C_UB + g * 128 + cseg * 16; \
        _Pragma("unroll") for (int jj = 0; jj < WP; ++jj) { const h16* _p = _up - (size_t)(jj < _cnt ? jj : 0) * NP; v[2 * jj] = *(const h16x8*)_p; v[2 * jj + 1] = *(const h16x8*)(_p + 8); } } while (0)
#define POOL_SUM(item_, buf_) do { const int _row = ((item_) >> 2) * 64 + tok, _t = _row % T; const int _cnt = (_t + 1 < W) ? (_t + 1) : W; \
        float sum[16], u0[16]; \
        _Pragma("unroll") for (int e = 0; e < 8; ++e) { u0[e] = (float)v[0][e]; u0[8 + e] = (float)v[1][e]; sum[e] = u0[e]; sum[8 + e] = u0[8 + e]; } \
        _Pragma("unroll") for (int jj = 1; jj < WP; ++jj) { const bool ok = jj < _cnt; _Pragma("unroll") for (int e = 0; e < 8; ++e) { sum[e] += ok ? (float)v[2 * jj][e] : 0.f; sum[8 + e] += ok ? (float)v[2 * jj + 1][e] : 0.f; } } \
        if (W > WP) { const h16* _up = PROJ + (size_t)_row * NP + C_UB + g * 128 + cseg * 16; \
            _Pragma("unroll") for (int jj = WP; jj < W; ++jj) { const bool ok = jj < _cnt; const h16* _p = _up - (size_t)(ok ? jj : 0) * NP; const h16x8 w0 = *(const h16x8*)_p, w1 = *(const h16x8*)(_p + 8); \
                _Pragma("unroll") for (int e = 0; e < 8; ++e) { sum[e] += ok ? (float)w0[e] : 0.f; sum[8 + e] += ok ? (float)w1[e] : 0.f; } } } \
        const float ic = 1.0f / (float)_cnt; u32x4 o0, o1; \
        o0.x = pk2h(sum[0] * ic - u0[0], sum[1] * ic - u0[1]); o0.y = pk2h(sum[2] * ic - u0[2], sum[3] * ic - u0[3]); \
        o0.z = pk2h(sum[4] * ic - u0[4], sum[5] * ic - u0[5]); o0.w = pk2h(sum[6] * ic - u0[6], sum[7] * ic - u0[7]); \
        o1.x = pk2h(sum[8] * ic - u0[8], sum[9] * ic - u0[9]); o1.y = pk2h(sum[10] * ic - u0[10], sum[11] * ic - u0[11]); \
        o1.z = pk2h(sum[12] * ic - u0[12], sum[13] * ic - u0[13]); o1.w = pk2h(sum[14] * ic - u0[14], sum[15] * ic - u0[15]); \
        LAS h16* _dst = PT0 + (buf_) * (64 * 136) + tok * 136 + cseg * 16; *(LAS u32x4*)_dst = o0; *(LAS u32x4*)(_dst + 8) = o1; } while (0)
    int item = 4 * w + g, buf = 0;
    if (item < NIT) { POOL_LOAD(item); POOL_SUM(item, 0); }
    __syncthreads();
    for (; item < NIT; item += step, buf ^= 1) {
        const int nitem = item + step; const bool has_next = nitem < NIT;
        const int row0 = (item >> 2) * 64;
        if (has_next) POOL_LOAD(nitem);
        h16x4 gb[4];
#pragma unroll
        for (int mt = 0; mt < 4; ++mt) gb[mt] = *(const h16x4*)(PROJ + (size_t)(row0 + 16 * mt + fr) * NP + C_GB + col);
        const LAS h16* PT = PT0 + buf * (64 * 136);
#pragma unroll
        for (int mt = 0; mt < 4; ++mt) {
            f32x4 acc = {0.f, 0.f, 0.f, 0.f};
#pragma unroll
            for (int kk = 0; kk < 4; ++kk) { const h16x8 af = *(const LAS h16x8*)(PT + (16 * mt + fr) * 136 + 32 * kk + 8 * fq);
                acc = __builtin_amdgcn_mfma_f32_16x16x32_f16(wf[kk], af, acc, 0, 0, 0); }
            const size_t row = (size_t)(row0 + 16 * mt + fr);
            u32x2 o; o.x = pk2h((acc[0] + pb[0]) * ps[0] * (float)gb[mt][0], (acc[1] + pb[1]) * ps[1] * (float)gb[mt][1]);
            o.y = pk2h((acc[2] + pb[2]) * ps[2] * (float)gb[mt][2], (acc[3] + pb[3]) * ps[3] * (float)gb[mt][3]);
            *(u32x2*)(BB + row * 512 + col) = o;
        }
        if (has_next) POOL_SUM(nitem, buf ^ 1);
        __syncthreads();
    }
#undef POOL_LOAD
#undef POOL_SUM
}
__device__ __forceinline__ void prep_phase(const Args& a, int l, LAS unsigned char* lds, int wave_s) {
    const int tid = otid(wave_s), bid = obid(), wave = tid >> 6, lane = tid & 63;
    h16* PROJ = (h16*)(a.ws + WS_PROJ);
    const f32x2* cs = (const f32x2*)(a.ws + WS_ROPE);
    {
        h16* KC = (h16*)(a.ws + WS_KC); h16* VC = (h16*)(a.ws + WS_VC); h16* KIC = (h16*)(a.ws + WS_KIC);
        const int gw = bid * 8 + wave, NGW = gridDim.x * 8;
        const int j = lane & 31, isidx = lane >> 5;
        const float g1 = a.kn_g[l * 64 + j], g2 = a.kn_g[l * 64 + 32 + j];
        for (int row0 = gw; row0 < R; row0 += 4 * NGW) {
            float x1[4], x2[4]; f32x2 c[4]; h16* base[4]; bool ok[4]; int rowi[4]; h16 vv[4];
#pragma unroll
            for (int r = 0; r < 4; ++r) { const int rr = row0 + r * NGW; ok[r] = rr < R; const int row = ok[r] ? rr : row0; rowi[r] = row;
                base[r] = PROJ + (size_t)row * NP + (isidx ? C_KI : C_K);
                x1[r] = (float)base[r][j]; x2[r] = (float)base[r][j + 32]; c[r] = cs[(row % T) * 32 + j]; vv[r] = PROJ[(size_t)row * NP + C_V + lane]; }
#pragma unroll
            for (int r = 0; r < 4; ++r) {
                float ss = x1[r] * x1[r] + x2[r] * x2[r];
#pragma unroll
                for (int o = 1; o < 32; o <<= 1) ss += __shfl_xor(ss, o);
                float y1 = x1[r], y2 = x2[r];
                if (!isidx) { const float rs = 1.0f / sqrtf(ss * (1.0f / 64.0f) + EPS); y1 *= rs * g1; y2 *= rs * g2; }
                if (ok[r]) { const h16 o1 = (h16)(y1 * c[r].x - y2 * c[r].y), o2 = (h16)(y2 * c[r].x + y1 * c[r].y);
                    if (isidx) { const int bb = rowi[r] / T, tt = rowi[r] - bb * T;
                        KIC[((size_t)(bb * 8 + (j >> 3)) * T + tt) * 8 + (j & 7)] = o1; KIC[((size_t)(bb * 8 + 4 + (j >> 3)) * T + tt) * 8 + (j & 7)] = o2; }
                    else { h16* dst = KC + (size_t)rowi[r] * 64; dst[j] = o1; dst[j + 32] = o2; }
                    VC[(size_t)rowi[r] * 64 + lane] = vv[r]; }
            }
        }
    }
    {
        const int G = (int)gridDim.x, t0 = (G * 47) >> 8, t1 = (G * 101) >> 8, t2 = (G * 166) >> 8;
        if (t0 >= 1 && t1 > t0 && t2 > t1 && G > t2) {
            if (bid < t0) pool_loop<2>(a, l, lds, tid, bid, t0, wave, lane); else if (bid < t1) pool_loop<4>(a, l, lds, tid, bid - t0, t1 - t0, wave, lane);
            else if (bid < t2) pool_loop<8>(a, l, lds, tid, bid - t1, t2 - t1, wave, lane); else pool_loop<16>(a, l, lds, tid, bid - t2, G - t2, wave, lane);
        }
    }
}

__device__ __forceinline__ float wave_min(float v) {
#pragma unroll
    for (int o = 1; o < 64; o <<= 1) v = fminf(v, __shfl_xor(v, o));
    return v;
}
__device__ __forceinline__ float wave_max(float v) {
#pragma unroll
    for (int o = 1; o < 64; o <<= 1) v = fmaxf(v, __shfl_xor(v, o));
    return v;
}
__device__ __forceinline__ int mbcnt(unsigned long long m) { return (int)__builtin_amdgcn_mbcnt_hi((unsigned)(m >> 32), __builtin_amdgcn_mbcnt_lo((unsigned)m, 0u)); }

__device__ __forceinline__ int wave_incl_scan(int v) {
    v += __builtin_amdgcn_update_dpp(0, v, 0x111, 0xf, 0xf, false);
    v += __builtin_amdgcn_update_dpp(0, v, 0x112, 0xf, 0xf, false);
    v += __builtin_amdgcn_update_dpp(0, v, 0x114, 0xf, 0xf, false);
    v += __builtin_amdgcn_update_dpp(0, v, 0x118, 0xf, 0xf, false);
    v += __builtin_amdgcn_update_dpp(0, v, 0x142, 0xa, 0xf, false);
    v += __builtin_amdgcn_update_dpp(0, v, 0x143, 0xc, 0xf, false);
    return v;
}
__device__ __forceinline__ void select_topk(const LAS float* sc, int n, LAS unsigned* hist, LAS unsigned short* sel, int lane, float lo, float hi) {
    LAS unsigned short* cand = (LAS unsigned short*)hist;
    const LAS f32x4* sc4 = (const LAS f32x4*)sc;
    const int n4 = n >> 2;
    int need = 256, nsel = 0;
    const int nit = (n + 63) >> 6, nit4 = (n4 + 63) >> 6;
    for (int iter = 0; iter < 64; ++iter) {
        if (!(lo < hi)) {
            for (int it = 0; it < nit; ++it) { const int idx = it * 64 + lane; const bool act = idx < n && sc[idx < n ? idx : 0] == lo;
                const unsigned long long mk = __ballot(act); const int pos = nsel + mbcnt(mk);
                if (act && pos < 256) sel[pos] = (unsigned short)idx;
                nsel += __popcll(mk); }
            break;
        }
#pragma unroll
        for (int j = 0; j < 8; ++j) hist[lane * 8 + j] = 0u;
        LDS_FENCE();
        const float scale = 512.0f / (hi - lo), nls = -lo * scale;
        if (iter == 0) {
#pragma unroll 2
            for (int q = lane; q < n4; q += 64) { const f32x4 v4 = sc4[q];
#pragma unroll
                for (int e = 0; e < 4; ++e) { int bin = (int)__builtin_fmaf(v4[e], scale, nls); bin = bin > 511 ? 511 : bin;
                    __hip_atomic_fetch_add(hist + bin, 1u, __ATOMIC_RELAXED, __HIP_MEMORY_SCOPE_WORKGROUP); } }
        } else {
#pragma unroll 2
            for (int q = lane; q < n4; q += 64) { const f32x4 v4 = sc4[q];
#pragma unroll
                for (int e = 0; e < 4; ++e) { const float v = v4[e];
                    if (v >= lo && v <= hi) { int bin = (int)__builtin_fmaf(v, scale, nls); bin = bin > 511 ? 511 : bin;
                        __hip_atomic_fetch_add(hist + bin, 1u, __ATOMIC_RELAXED, __HIP_MEMORY_SCOPE_WORKGROUP); } } }
        }
        LDS_FENCE();
        unsigned wd[8]; int tot = 0;
#pragma unroll
        for (int j = 0; j < 8; ++j) { wd[j] = hist[lane * 8 + j]; tot += (int)wd[j]; }
        const int incl_t = wave_incl_scan(tot);
        const int above = __builtin_amdgcn_readlane(incl_t, 63) - incl_t, suf = above + tot;
        const bool has = (above < need) && (suf >= need);
        int bstar = 0, cgt = 0;
        {
            int run = above; bool found = false;
#pragma unroll
            for (int bb = 7; bb >= 0; --bb) { const int c = (int)wd[bb];
                if (!found && run + c >= need) { found = true; bstar = lane * 8 + bb; cgt = run; }
                run += c; }
        }
        const unsigned long long hm = __ballot(has);
        const int src = (int)__builtin_ctzll(hm ? hm : 1ull);
        { const int srcu = __builtin_amdgcn_readfirstlane(src); bstar = __builtin_amdgcn_readlane(bstar, srcu); cgt = __builtin_amdgcn_readlane(cgt, srcu); }
        LDS_FENCE();
        float lo2 = 3.0e38f, hi2 = -3.0e38f; int ncand = 0;
        if (iter == 0) {
            const float thr_gt = bstar >= 511 ? 3.0e38f : (float)(bstar + 1), thr_eq = bstar == 0 ? -3.0e38f : (float)bstar;
            int cl = 0;
#pragma unroll 2
            for (int q = lane; q < n4; q += 64) { const f32x4 v4 = sc4[q];
#pragma unroll
                for (int e = 0; e < 4; ++e) cl += (__builtin_fmaf(v4[e], scale, nls) >= thr_gt) ? 1 : 0; }
            const int incl = wave_incl_scan(cl);
            int wpos = nsel + incl - cl;
            for (int it = 0; it < nit4; ++it) { const int q = it * 64 + lane; const bool inr = q < n4; const f32x4 v4 = sc4[inr ? q : 0];
                bool eqv[4]; bool anyeq = false;
#pragma unroll
                for (int e = 0; e < 4; ++e) { const float t = __builtin_fmaf(v4[e], scale, nls); const bool gt = inr && t >= thr_gt; eqv[e] = inr && !gt && t >= thr_eq; anyeq = anyeq || eqv[e];
                    if (gt) { sel[wpos] = (unsigned short)(4 * q + e); ++wpos; } }
                if (__ballot(anyeq)) {
#pragma unroll
                    for (int e = 0; e < 4; ++e) { const unsigned long long me = __ballot(eqv[e]);
                        if (eqv[e]) { const int p = ncand + mbcnt(me); if (p < 1024) cand[p] = (unsigned short)(4 * q + e); lo2 = fminf(lo2, v4[e]); hi2 = fmaxf(hi2, v4[e]); }
                        ncand += __popcll(me); } } }
            nsel += cgt;
        } else {
        for (int it = 0; it < nit4; ++it) { const int q = it * 64 + lane; const bool inr = q < n4; const f32x4 v4 = sc4[inr ? q : 0];
            bool eqv[4]; bool anyeq = false;
#pragma unroll
            for (int e = 0; e < 4; ++e) { const float v = v4[e]; const int idx = 4 * q + e;
                const bool act = inr && v >= lo && v <= hi;
                int bin = (int)__builtin_fmaf(v, scale, nls); bin = bin > 511 ? 511 : bin;
                const bool gt = act && bin > bstar; eqv[e] = act && bin == bstar; anyeq = anyeq || eqv[e];
                const unsigned long long mg = __ballot(gt);
                if (gt) sel[nsel + mbcnt(mg)] = (unsigned short)idx;
                nsel += __popcll(mg); }
            if (__ballot(anyeq)) {
#pragma unroll
                for (int e = 0; e < 4; ++e) { const unsigned long long me = __ballot(eqv[e]);
                    if (eqv[e]) { const int p = ncand + mbcnt(me); if (p < 1024) cand[p] = (unsigned short)(4 * q + e); lo2 = fminf(lo2, v4[e]); hi2 = fmaxf(hi2, v4[e]); }
                    ncand += __popcll(me); } } }
        }
        need -= cgt;
        LDS_FENCE();
        if (ncand == need) { for (int i = lane; i < ncand; i += 64) sel[nsel + i] = cand[i]; break; }
        if (ncand <= 256) {
            const int rounds = (ncand + 63) >> 6;
            for (int rd = 0; rd < rounds; ++rd) { const int i = rd * 64 + lane; const bool ok = i < ncand;
                const int idx = cand[ok ? i : 0]; const float v = sc[idx]; int rank = 0;
                for (int j = 0; j < ncand; ++j) { const int ij = cand[j]; const float vj = sc[ij]; rank += (vj > v || (vj == v && ij < idx)) ? 1 : 0; }
                if (ok && rank < need) sel[nsel + rank] = (unsigned short)idx; }
            break;
        }
        lo = wave_min(lo2); hi = wave_max(hi2);
    }
    LDS_FENCE();
}

__device__ __forceinline__ void attn_phase(const Args& a, int l, LAS unsigned char* lds, int wave_s) {
    const int tid = otid(wave_s), bid = obid(), wave = __builtin_amdgcn_readfirstlane(tid >> 6), lane0 = tid & 63;
    LAS float* SC = (LAS float*)(lds + L_SC);
    LAS unsigned char* HQ = lds + L_HQ;
    LAS unsigned short* sel = (LAS unsigned short*)(lds + L_SEL) + wave * 256;
    LAS h16* QA = (LAS h16*)(lds + L_QA) + wave * 512;
    const h16* PROJ = (const h16*)(a.ws + WS_PROJ);
    const h16* KC = (const h16*)(a.ws + WS_KC); const h16* VC = (const h16*)(a.ws + WS_VC); const h16* KIC = (const h16*)(a.ws + WS_KIC);
    h16* AA = (h16*)(a.ws + WS_AA);
    const f32x2* cs = (const f32x2*)(a.ws + WS_ROPE);
    const int xg = bid & 7; constexpr int NJ = 2 * (T / 8);
    unsigned* cntp = (unsigned*)(a.ws + WS_BAR) + 4096 + (l * 8 + xg) * 64;
    volatile LAS unsigned* TK = (volatile LAS unsigned*)(lds + L_BARST + 16);
    if (wave == 0 && lane0 == 0) TK[0] = __hip_atomic_fetch_add(cntp, 1u, __ATOMIC_RELAXED, __HIP_MEMORY_SCOPE_AGENT);
    __syncthreads();
    int cur = __builtin_amdgcn_readfirstlane((int)TK[0]);
    h16x8 n_xqi, n_xq; h16 n_wi = (h16)0.f; f32x4 n_rc[4];
    {
        const int lane = lane0;
        const int j = cur < NJ ? cur : 0; const int b = xg + 8 * (j & 1), g = (T / 8 - 1) - (j >> 1), t = 8 * g + wave; const size_t row = (size_t)(b * T + t);
        n_xqi = *(const h16x8*)(PROJ + row * NP + C_QI + lane * 8); n_xq = *(const h16x8*)(PROJ + row * NP + C_Q + lane * 8);
        if (lane < 8) n_wi = PROJ[row * NP + C_WI + lane];
#pragma unroll
        for (int e = 0; e < 4; ++e) n_rc[e] = *(const f32x4*)(cs + t * 32 + (lane & 3) * 8 + 2 * e);
    }
    for (int it = 0; cur < NJ; ++it) {
        if (wave == 0 && lane0 == 0) TK[(it + 1) & 1] = __hip_atomic_fetch_add(cntp, 1u, __ATOMIC_RELAXED, __HIP_MEMORY_SCOPE_AGENT);
        const int b = xg + 8 * (cur & 1), g = (T / 8 - 1) - (cur >> 1);
        const int t0 = 8 * g, n = (t0 < NMETA) ? NMETA : NMETA + 64 * (1 + ((t0 - NMETA) >> 6));
        const int rowbase = b * T, t = t0 + wave;
        const size_t myrow = (size_t)(rowbase + t);
        const int cnt = n < 256 ? n : 256;
        const char* KCb = (const char*)(KC + (size_t)rowbase * 64); const char* VCb = (const char*)(VC + (size_t)rowbase * 64);
        {
            int lane1 = lane0; asm volatile("" : "+v"(lane1)); const int lane = lane1;
            const int piece = lane & 7;
            LAS h16* QS = (LAS h16*)HQ; LAS float* WSs = (LAS float*)(HQ + 8192);
            float c[8], sn[8];
#pragma unroll
            for (int e = 0; e < 4; ++e) { c[2 * e] = n_rc[e][0]; sn[2 * e] = n_rc[e][1]; c[2 * e + 1] = n_rc[e][2]; sn[2 * e + 1] = n_rc[e][3]; }
            if (n > 256) {
                float y[8];
#pragma unroll
                for (int e = 0; e < 8; ++e) { const float xe = (float)n_xqi[e], xp = __shfl_xor(xe, 4); y[e] = piece < 4 ? xe * c[e] - xp * sn[e] : xe * c[e] + xp * sn[e]; }
                u32x4 o; o.x = pk2h(y[0], y[1]); o.y = pk2h(y[2], y[3]); o.z = pk2h(y[4], y[5]); o.w = pk2h(y[6], y[7]);
                *(LAS u32x4*)(QS + wave * 512 + lane * 8) = o;
                if (lane < 8) WSs[wave * 8 + lane] = (float)n_wi * 0.04419417382415922f;
            }
            {
                const f32x4 g0 = *(const f32x4*)(a.qn_g + l * 64 + piece * 8), g1 = *(const f32x4*)(a.qn_g + l * 64 + piece * 8 + 4);
                float xf[8], ss = 0.f;
#pragma unroll
                for (int e = 0; e < 8; ++e) { xf[e] = (float)n_xq[e]; ss += xf[e] * xf[e]; }
                ss += __shfl_xor(ss, 1); ss += __shfl_xor(ss, 2); ss += __shfl_xor(ss, 4);
                const float rs = 1.0f / sqrtf(ss * (1.0f / 64.0f) + EPS);
                float y[8];
#pragma unroll
                for (int e = 0; e < 8; ++e) { const float ye = xf[e] * rs * (e < 4 ? g0[e & 3] : g1[e & 3]), yp = __shfl_xor(ye, 4); y[e] = piece < 4 ? ye * c[e] - yp * sn[e] : ye * c[e] + yp * sn[e]; }
                u32x4 o; o.x = pk2h(y[0], y[1]); o.y = pk2h(y[2], y[3]); o.z = pk2h(y[4], y[5]); o.w = pk2h(y[6], y[7]);
                *(LAS u32x4*)(QA + lane * 8) = o;
            }
        }
        if (n > 256) {
            LAS h16* QS = (LAS h16*)HQ; LAS float* WSs = (LAS float*)(HQ + 8192);
            __syncthreads();
            {
                int lane2 = lane0; asm volatile("" : "+v"(lane2)); const int lane = lane2;
                const int i = lane & 31, gg = i >> 3, hr = (i >> 2) & 1, jj = i & 3, hg = lane >> 5;
                const int qrow = (gg >> 1) * 2 + hr, head = (gg & 1) * 4 + jj;
                h16x8 Af[2][4];
#pragma unroll
                for (int rt = 0; rt < 2; ++rt)
#pragma unroll
                    for (int kk = 0; kk < 4; ++kk) Af[rt][kk] = *(const LAS h16x8*)(QS + (rt * 4 + qrow) * 512 + head * 64 + kk * 16 + hg * 8);
                f32x4 wv[2][2][2];
#pragma unroll
                for (int rt = 0; rt < 2; ++rt)
#pragma unroll
                    for (int hf = 0; hf < 2; ++hf) { const int q = rt * 4 + hf * 2 + hg; wv[rt][hf][0] = *(const LAS f32x4*)(WSs + q * 8); wv[rt][hf][1] = *(const LAS f32x4*)(WSs + q * 8 + 4); }
                const int ntile = (n + 31) >> 5;
                float mn0 = 3.0e38f, mn1 = 3.0e38f, mn2 = 3.0e38f, mn3 = 3.0e38f, mx0 = -3.0e38f, mx1 = -3.0e38f, mx2 = -3.0e38f, mx3 = -3.0e38f;
                h16x8 Bn[4];
                { const int key = wave * 32 + i, keyc = key < n ? key : n - 1;
                  const h16* kp = KIC + ((size_t)(b * 8 + hg) * T + keyc) * 8;
#pragma unroll
                  for (int kk = 0; kk < 4; ++kk) Bn[kk] = *(const h16x8*)(kp + (size_t)kk * 2 * T * 8); }
                for (int tile = wave; tile < ntile; tile += 8) {
                    const int key = tile * 32 + i;
                    h16x8 Bf[4];
#pragma unroll
                    for (int kk = 0; kk < 4; ++kk) Bf[kk] = Bn[kk];
                    { const int keyn = key + 256, keyc = keyn < n ? keyn : n - 1;
                      const h16* kp = KIC + ((size_t)(b * 8 + hg) * T + keyc) * 8;
#pragma unroll
                      for (int kk = 0; kk < 4; ++kk) Bn[kk] = *(const h16x8*)(kp + (size_t)kk * 2 * T * 8); }
                    f32x16 acc0, acc1;
#pragma unroll
                    for (int e = 0; e < 16; ++e) { acc0[e] = 0.f; acc1[e] = 0.f; }
#pragma unroll
                    for (int kk = 0; kk < 4; ++kk) { acc0 = __builtin_amdgcn_mfma_f32_32x32x16_f16(Af[0][kk], Bf[kk], acc0, 0, 0, 0); acc1 = __builtin_amdgcn_mfma_f32_32x32x16_f16(Af[1][kk], Bf[kk], acc1, 0, 0, 0); }
                    float s00 = 0.f, s01 = 0.f, s10 = 0.f, s11 = 0.f;
#pragma unroll
                    for (int r = 0; r < 8; ++r) { const float w0 = wv[0][0][r >> 2][r & 3], w1 = wv[0][1][r >> 2][r & 3], w2 = wv[1][0][r >> 2][r & 3], w3 = wv[1][1][r >> 2][r & 3];
                        s00 += w0 * fmaxf(acc0[r], 0.f); s01 += w1 * fmaxf(acc0[8 + r], 0.f); s10 += w2 * fmaxf(acc1[r], 0.f); s11 += w3 * fmaxf(acc1[8 + r], 0.f); }
                    SC[(0 + hg) * SCW + key] = s00; SC[(2 + hg) * SCW + key] = s01; SC[(4 + hg) * SCW + key] = s10; SC[(6 + hg) * SCW + key] = s11;
                    mn0 = fminf(mn0, s00); mx0 = fmaxf(mx0, s00); mn1 = fminf(mn1, s01); mx1 = fmaxf(mx1, s01);
                    mn2 = fminf(mn2, s10); mx2 = fmaxf(mx2, s10); mn3 = fminf(mn3, s11); mx3 = fmaxf(mx3, s11);
                }
#pragma unroll
                for (int o = 1; o < 32; o <<= 1) { mn0 = fminf(mn0, __shfl_xor(mn0, o)); mx0 = fmaxf(mx0, __shfl_xor(mx0, o)); mn1 = fminf(mn1, __shfl_xor(mn1, o)); mx1 = fmaxf(mx1, __shfl_xor(mx1, o));
                    mn2 = fminf(mn2, __shfl_xor(mn2, o)); mx2 = fmaxf(mx2, __shfl_xor(mx2, o)); mn3 = fminf(mn3, __shfl_xor(mn3, o)); mx3 = fmaxf(mx3, __shfl_xor(mx3, o)); }
                if (i == 0) { LAS f32x2* MM = (LAS f32x2*)(lds + L_MM) + wave * 8;
                    MM[0 + hg] = (f32x2){mn0, mx0}; MM[2 + hg] = (f32x2){mn1, mx1}; MM[4 + hg] = (f32x2){mn2, mx2}; MM[6 + hg] = (f32x2){mn3, mx3}; }
            }
            __syncthreads();
            {
                float lo = 3.0e38f, hi = -3.0e38f;
                const LAS f32x2* MM = (const LAS f32x2*)(lds + L_MM);
#pragma unroll
                for (int w8 = 0; w8 < 8; ++w8) { const f32x2 m = MM[w8 * 8 + wave]; lo = fminf(lo, m[0]); hi = fmaxf(hi, m[1]); }
                int lane4 = lane0; asm volatile("" : "+v"(lane4));
                select_topk(SC + wave * SCW, n, (LAS unsigned*)(HQ + wave * 2048), sel, lane4, lo, hi);
            }
        } else {
            for (int i = lane0; i < n; i += 64) sel[i] = (unsigned short)i;
            LDS_FENCE();
            __syncthreads();
        }
        const int nxt = __builtin_amdgcn_readfirstlane((int)TK[(it + 1) & 1]);
        int lane5 = lane0; asm volatile("" : "+v"(lane5));
        {
        const int lane = lane5, fr = lane & 15, fq = lane >> 4, piece = lane & 7;
        h16x8 Qf[2];
        Qf[0] = *(const LAS h16x8*)(QA + (fr & 7) * 64 + fq * 8); Qf[1] = *(const LAS h16x8*)(QA + (fr & 7) * 64 + 32 + fq * 8);
        f32x4 s[16];
        u32x4 vr[16];
#define ATT_KEYS(keys, c) do { const int _p0 = (lane >> 3) * 32 + 16 * (c); \
            if (cnt < 256) { _Pragma("unroll") for (int i = 0; i < 16; ++i) { const int _p = _p0 + i; keys[i] = sel[_p < cnt ? _p : cnt - 1]; } } \
            else { const u32x4 _w0 = *(const LAS u32x4*)(sel + _p0), _w1 = *(const LAS u32x4*)(sel + _p0 + 8); \
                _Pragma("unroll") for (int i = 0; i < 4; ++i) { keys[2 * i] = (int)(_w0[i] & 0xffffu); keys[2 * i + 1] = (int)(_w0[i] >> 16); keys[8 + 2 * i] = (int)(_w1[i] & 0xffffu); keys[8 + 2 * i + 1] = (int)(_w1[i] >> 16); } } } while (0)
        LAS unsigned char* VS = (LAS unsigned char*)(SC + wave * SCW);
        {
            u32x4 kr[2][16];
#pragma unroll
            for (int c = 0; c < 2; ++c) {
                int keys[16];
#pragma unroll
                ATT_KEYS(keys, c);
                __builtin_amdgcn_sched_barrier(0);
#pragma unroll
                for (int i = 0; i < 16; ++i) kr[c][i] = *(const u32x4*)(KCb + (unsigned)(keys[i] * 128 + piece * 16));
                __builtin_amdgcn_sched_barrier(0);
            }
#pragma unroll
            for (int c = 0; c < 2; ++c) {
#pragma unroll
                for (int i = 0; i < 16; ++i) { const int sl = 8 * i + (lane >> 3); *(LAS u32x4*)(VS + sl * 128 + ((piece ^ ((sl >> 1) & 7)) * 16)) = kr[c][i]; }
                LDS_FENCE();
#pragma unroll
                for (int tl = 0; tl < 8; ++tl) {
                    const int sl = 16 * tl + fr, sw = (sl >> 1) & 7;
                    const h16x8 a0 = *(const LAS h16x8*)(VS + sl * 128 + ((fq ^ sw) * 16)), a1 = *(const LAS h16x8*)(VS + sl * 128 + (((4 + fq) ^ sw) * 16));
                    f32x4 z = {0.f, 0.f, 0.f, 0.f};
                    z = __builtin_amdgcn_mfma_f32_16x16x32_f16(a0, Qf[0], z, 0, 0, 0);
                    s[8 * c + tl] = __builtin_amdgcn_mfma_f32_16x16x32_f16(a1, Qf[1], z, 0, 0, 0);
                }
                LDS_ORDER();
            }
            __builtin_amdgcn_sched_barrier(0);
            int keysv[16];
#pragma unroll
            ATT_KEYS(keysv, 0);
            __builtin_amdgcn_sched_barrier(0);
#pragma unroll
            for (int i = 0; i < 16; ++i) vr[i] = *(const u32x4*)(VCb + (unsigned)(keysv[i] * 128 + piece * 16));
            __builtin_amdgcn_sched_barrier(0);
        }
        float mx = -3.0e38f;
        if (cnt < 256) {
#pragma unroll
            for (int tau = 0; tau < 16; ++tau)
#pragma unroll
                for (int j = 0; j < 4; ++j) { const int x = 4 * fq + j, pos = (x & 7) * 32 + (tau >> 3) * 16 + 2 * (tau & 7) + (x >> 3); if (pos >= cnt) s[tau][j] = -1.0e30f; }
        }
#pragma unroll
        for (int tau = 0; tau < 16; ++tau)
#pragma unroll
            for (int j = 0; j < 4; ++j) mx = fmaxf(mx, s[tau][j]);
        mx = fmaxf(mx, __shfl_xor(mx, 16)); mx = fmaxf(mx, __shfl_xor(mx, 32));
        float sum = 0.f;
        const float cscale = 0.125f * 1.44269504088896340736f;
        const float mxc = mx * cscale;
#pragma unroll
        for (int tau = 0; tau < 16; ++tau)
#pragma unroll
            for (int j = 0; j < 4; ++j) { const float p = __builtin_amdgcn_exp2f(__builtin_fmaf(s[tau][j], cscale, -mxc)); s[tau][j] = p; sum += p; }
        sum += __shfl_xor(sum, 16); sum += __shfl_xor(sum, 32);
        const float inv = 1.0f / sum;
        h16x8 Pf[8];
#pragma unroll
        for (int kk = 0; kk < 8; ++kk)
#pragma unroll
            for (int e = 0; e < 4; ++e) { Pf[kk][e] = (h16)s[2 * kk][e]; Pf[kk][4 + e] = (h16)s[2 * kk + 1][e]; }
        f32x4 o[4];
#pragma unroll
        for (int d = 0; d < 4; ++d) o[d] = (f32x4){0.f, 0.f, 0.f, 0.f};
        const int lg = lane & 15;
        h16x8 gav;
#pragma unroll
        for (int c = 0; c < 2; ++c) {
#pragma unroll
            for (int i = 0; i < 16; ++i) { const int sl = 8 * i + (lane >> 3);
                *(LAS u32x4*)(VS + sl * 128 + (((piece >> 1) ^ ((sl >> 1) & 3)) * 32) + (piece & 1) * 16) = vr[i]; }
            if (c == 0) {
                int keys[16];
#pragma unroll
                ATT_KEYS(keys, 1);
                __builtin_amdgcn_sched_barrier(0);
#pragma unroll
                for (int i = 0; i < 16; ++i) vr[i] = *(const u32x4*)(VCb + (unsigned)(keys[i] * 128 + piece * 16));
                gav = *(const h16x8*)(PROJ + myrow * NP + C_GA + lane * 8);
                __builtin_amdgcn_sched_barrier(0);
            } else {
                {
                    const int nj = nxt < NJ ? nxt : cur;
                    const int nb = xg + 8 * (nj & 1), ng = (T / 8 - 1) - (nj >> 1), nt = 8 * ng + wave; const size_t nrow = (size_t)(nb * T + nt);
                    n_xqi = *(const h16x8*)(PROJ + nrow * NP + C_QI + lane * 8); n_xq = *(const h16x8*)(PROJ + nrow * NP + C_Q + lane * 8);
                    if (lane < 8) n_wi = PROJ[nrow * NP + C_WI + lane];
#pragma unroll
                    for (int e = 0; e < 4; ++e) n_rc[e] = *(const f32x4*)(cs + nt * 32 + (lane & 3) * 8 + 2 * e);
                }
                __builtin_amdgcn_sched_barrier(0);
            }
            LDS_FENCE();
            {
                h16x8 vfa[4], vfb[4];
#define PV_READ(dst, kk_) do { const int rowA = 32 * (kk_) + 4 * fq + (lg >> 2), rowB = rowA + 16; _Pragma("unroll") for (int d = 0; d < 4; ++d) { \
                    const fp16x4 vlo = __builtin_amdgcn_ds_read_tr16_b64_v4f16((LAS fp16x4*)(VS + rowA * 128 + ((d ^ ((rowA >> 1) & 3)) * 32) + (lg & 3) * 8)); \
                    const fp16x4 vhi = __builtin_amdgcn_ds_read_tr16_b64_v4f16((LAS fp16x4*)(VS + rowB * 128 + ((d ^ ((rowB >> 1) & 3)) * 32) + (lg & 3) * 8)); \
                    const h16x4 wl = __builtin_bit_cast(h16x4, vlo), wh = __builtin_bit_cast(h16x4, vhi); \
                    dst[d][0] = wl[0]; dst[d][1] = wl[1]; dst[d][2] = wl[2]; dst[d][3] = wl[3]; dst[d][4] = wh[0]; dst[d][5] = wh[1]; dst[d][6] = wh[2]; dst[d][7] = wh[3]; } } while (0)
#define PV_MMA(src, kk_) do { _Pragma("unroll") for (int d = 0; d < 4; ++d) o[d] = __builtin_amdgcn_mfma_f32_16x16x32_f16(Pf[4 * c + (kk_)], src[d], o[d], 0, 0, 0); } while (0)
                PV_READ(vfa, 0); __builtin_amdgcn_sched_barrier(0);
                PV_READ(vfb, 1); __builtin_amdgcn_sched_barrier(0);
                PV_MMA(vfa, 0);  __builtin_amdgcn_sched_barrier(0);
                PV_READ(vfa, 2); __builtin_amdgcn_sched_barrier(0);
                PV_MMA(vfb, 1);  __builtin_amdgcn_sched_barrier(0);
                PV_READ(vfb, 3); __builtin_amdgcn_sched_barrier(0);
                PV_MMA(vfa, 2);  __builtin_amdgcn_sched_barrier(0);
                PV_MMA(vfb, 3);  __builtin_amdgcn_sched_barrier(0);
#undef PV_READ
#undef PV_MMA
            }
            LDS_ORDER();
        }
        LAS h16* OT = (LAS h16*)VS; LAS float* IV = (LAS float*)(VS + 1024);
        if (fq < 2) {
#pragma unroll
            for (int d = 0; d < 4; ++d)
#pragma unroll
                for (int j = 0; j < 4; ++j) OT[(4 * fq + j) * 64 + 16 * d + fr] = (h16)(o[d][j] * 0.00390625f);
        }
        if (lane < 8) IV[lane] = inv * 256.0f;
        LDS_FENCE();
        {
            const float hinv = IV[lane >> 3];
            const h16x8 ov = *(const LAS h16x8*)(OT + lane * 8);
            float r[8];
#pragma unroll
            for (int e = 0; e < 8; ++e) r[e] = (float)ov[e] * hinv * (float)gav[e];
            u32x4 ow; ow.x = pk2h(r[0], r[1]); ow.y = pk2h(r[2], r[3]); ow.z = pk2h(r[4], r[5]); ow.w = pk2h(r[6], r[7]);
            *(u32x4*)(AA + myrow * 512 + lane * 8) = ow;
        }
        }
        __syncthreads();
        cur = nxt;
    }
}

#define XB_TMO      128
#define XB_XCNT(j)  (256  + 64 * (j))
#define XB_XSUB(j)  (1280 + 64 * (j))
#define XB_XGEN(j)  (2304 + 64 * (j))
#define XB_TOP      3328
#define XB_TOPGEN   3392
#define XCD_BAR_WORDS 3456
#define XB_SPIN_CAP (1u << 20)
__device__ __forceinline__ unsigned xb_ld(unsigned* p)              { return __hip_atomic_load(p, __ATOMIC_RELAXED, __HIP_MEMORY_SCOPE_AGENT); }
__device__ __forceinline__ unsigned xb_add(unsigned* p, unsigned v) { return __hip_atomic_fetch_add(p, v, __ATOMIC_RELAXED, __HIP_MEMORY_SCOPE_AGENT); }
__device__ __forceinline__ unsigned xb_xcc_id() { return (unsigned)__builtin_amdgcn_s_getreg((3 << 11) | 20) & 0xFu; }
#define XB_SPIN(cond, bar) do { unsigned _sp = 0; while (cond) { __builtin_amdgcn_s_sleep(1); \
    if ((++_sp & 255u) == 0u) { if (xb_ld(&(bar)[XB_TMO])) break; if (_sp > XB_SPIN_CAP) { atomicAdd(&(bar)[XB_TMO], 1u); break; } } } } while (0)
struct XcdBarrier { unsigned* bar; unsigned x; volatile LAS unsigned* st; };
__device__ __forceinline__ XcdBarrier xcd_barrier_post(unsigned* bar, volatile LAS unsigned* st) {
    XcdBarrier b; b.bar = bar; b.x = xb_xcc_id(); b.st = st;
    if (threadIdx.x == 0) (void)xb_add(&bar[XB_XCNT(b.x)], 1u);
    return b;
}
__device__ __forceinline__ void xcd_barrier_complete(unsigned* bar, unsigned x, unsigned& nloc, unsigned& nx) {
    const unsigned G = gridDim.x * gridDim.y * gridDim.z;
    unsigned sum, cnt, mine, sp = 0u;
    for (;;) {
        sum = 0u; cnt = 0u; mine = 0u;
#pragma unroll
        for (unsigned j = 0; j < 16; ++j) { const unsigned c = xb_ld(&bar[XB_XCNT(j)]); sum += c; cnt += (c > 0u) ? 1u : 0u; mine = (j == x) ? c : mine; }
        if (sum == G) break;
        __builtin_amdgcn_s_sleep(1);
        if ((++sp & 255u) == 0u) { if (xb_ld(&bar[XB_TMO])) break; if (sp > XB_SPIN_CAP) { atomicAdd(&bar[XB_TMO], 1u); break; } }
    }
    nloc = mine > 0u ? mine : 1u; nx = cnt > 0u ? cnt : 1u;
}
__device__ __forceinline__ void xcd_barrier(const XcdBarrier& b, int wave_s) {
    asm volatile("s_waitcnt vmcnt(0)" ::: "memory");
    __syncthreads();
    if (wave_s == 0 && olane() == 0) {
        unsigned* bar = b.bar;
        __builtin_amdgcn_s_waitcnt(0);
        unsigned nloc = b.st[0], nx = b.st[1];
        if (nloc == 0u) { xcd_barrier_complete(bar, b.x, nloc, nx); b.st[0] = nloc; b.st[1] = nx; }
        const unsigned old = xb_add(&bar[XB_XSUB(b.x)], 1u);
        const unsigned gen = old / nloc;
        if (old + 1u == (gen + 1u) * nloc) {
            __builtin_amdgcn_fence(__ATOMIC_RELEASE, "agent");
            asm volatile("s_waitcnt vmcnt(0)" ::: "memory");
            const unsigned og = xb_add(&bar[XB_TOP], 1u);
            const unsigned tg = og / nx;
            if (og + 1u == (tg + 1u) * nx) xb_add(&bar[XB_TOPGEN], 1u);
            else XB_SPIN(xb_ld(&bar[XB_TOPGEN]) == tg, bar);
            __builtin_amdgcn_fence(__ATOMIC_ACQUIRE, "agent");
            xb_add(&bar[XB_XGEN(b.x)], 1u);
            asm volatile("s_waitcnt vmcnt(0)" ::: "memory");
        } else {
            XB_SPIN(xb_ld(&bar[XB_XGEN(b.x)]) == gen, bar);
            __builtin_amdgcn_fence(__ATOMIC_ACQUIRE, "agent");
            asm volatile("s_waitcnt vmcnt(0)" ::: "memory");
        }
    }
    __syncthreads();
}

__device__ __forceinline__ void run_phase(int ph, LAS unsigned char* lds, int wave_s) {
    const Args a = opaque_args();
#ifndef SKIP_P0
    if (ph == 0) { p0_phase(a, lds, wave_s); norm_phase(a, 0, wave_s); return; }
#endif
    const int l = (ph - 1) / 6, k = (ph - 1) % 6;
    pg8::StaticOrder S;
    if (k == 0) {
        pg8::Gemm g{(const h16*)(a.ws + WS_H), (const h16*)(a.ws + WS_WIN) + (size_t)l * NP * DM, R, NP, DM, nullptr, nullptr};
        S.init(R, NP, (int)gridDim.x, obid());
        EpiProj E{(h16*)(a.ws + WS_PROJ)};
#ifndef SKIP_G1
        pg8::gemm_phase(lds, g, S, E, wave_s);
#if PROBE_DOUBLE == 1
        pg8::gemm_phase(lds, g, S, E, wave_s);
#endif
#endif
    } else if (k == 1) {
#ifndef SKIP_PREP
        prep_phase(a, l, lds, wave_s);
#endif
    } else if (k == 2) {
#ifndef SKIP_ATTN
        attn_phase(a, l, lds, wave_s);
#if PROBE_DOUBLE == 2
        attn_phase(a, l, lds, wave_s);
#endif
#endif
    } else if (k == 3) {
        S.init(RM, DM, (int)gridDim.x, obid());
        { pg8::Gemm g{(const h16*)(a.ws + WS_AA), (const h16*)(a.ws + WS_WA) + (size_t)l * DM * 512, RM, DM, 512, (const h16*)(a.ws + WS_BB), (const h16*)(a.ws + WS_WB) + (size_t)l * DM * 512};
          EpiMerge2 E{(h16*)(a.ws + WS_H), (const h16*)(a.ws + WS_PROJ) + C_MG};
#ifndef SKIP_G2
          gemm_tail<1>(a, l, wave_s);
          pg8::gemm_phase<EpiMerge2, pg8::StaticOrder, true>(lds, g, S, E, wave_s);
#endif
        }
    } else if (k == 4) {
        S.init(RM, DM, (int)gridDim.x, obid());
        pg8::Gemm g{(const h16*)(a.ws + WS_H), (const h16*)(a.ws + WS_WO) + (size_t)l * DM * DM, RM, DM, DM, nullptr, nullptr};
        EpiResid E{l == 0 ? a.x : a.out, l == 0 ? a.meta : (const float*)(a.ws + WS_META), l == 0 ? 0 : NMETA * DM, a.out, (float*)(a.ws + WS_META)};
#ifndef SKIP_G3
        gemm_tail<2>(a, l, wave_s);
        pg8::gemm_phase(lds, g, S, E, wave_s);
#endif
    } else {
        norm_phase(a, l + 1, wave_s);
    }
}
constexpr int N_PHASES = 1 + 6 * DEPTH - 1;

__global__ __launch_bounds__(512, 2) void mega_fwd(Args a) {
    extern __shared__ __attribute__((aligned(16))) unsigned char shm[];
    LAS unsigned char* lds = (LAS unsigned char*)shm;
    cg::grid_group grid = cg::this_grid();
    int wave_s = __builtin_amdgcn_readfirstlane((int)threadIdx.x >> 6); asm volatile("" : "+s"(wave_s));
    volatile LAS unsigned* st = (volatile LAS unsigned*)(lds + L_BARST);
    if (threadIdx.x == 0) { st[0] = 0u; st[1] = 0u; }
    __syncthreads();
    const XcdBarrier xb = xcd_barrier_post((unsigned*)(a.ws + WS_BAR), st);
    for (int ph = a.ph_lo; ph < a.ph_hi; ++ph) {
        run_phase(ph, lds, wave_s);
        if (ph + 1 < a.ph_hi) { if (a.ph_lo < 0) grid.sync(); else xcd_barrier(xb, wave_s); }
    }
}

extern "C" void kernel_launch(void* const* d_in, const int* in_sizes, int n_in, void* d_out, int out_size, void* d_ws, size_t ws_size, hipStream_t stream) {
    static int grid = 0;
    if (grid == 0) {
        if (n_in != 12 || ws_size < WS_END) { fprintf(stderr, "kernel_launch: unexpected n_in %d / ws %zu (need %zu)\n", n_in, ws_size, (size_t)WS_END); grid = -1; return; }
        int dev = 0, cus = 0, per_cu = 0;
        hipGetDevice(&dev);
        hipDeviceGetAttribute(&cus, hipDeviceAttributeMultiprocessorCount, dev);
        if (hipFuncSetAttribute((const void*)mega_fwd, hipFuncAttributeMaxDynamicSharedMemorySize, LDS_BYTES) != hipSuccess) { fprintf(stderr, "kernel_launch: hipFuncSetAttribute failed\n"); grid = -1; return; }
        if (hipOccupancyMaxActiveBlocksPerMultiprocessor(&per_cu, (const void*)mega_fwd, 512, LDS_BYTES) != hipSuccess || per_cu < 1) { fprintf(stderr, "kernel_launch: occupancy query says %d\n", per_cu); per_cu = 1; }
        (void)hipGetLastError();
        grid = cus * 1;
    }
    if (grid < 0) return;
    (void)hipMemsetAsync((unsigned char*)d_ws + WS_BAR, 0, 32768, stream);
    Args a{};
    a.x = (const float*)d_in[0]; a.meta = (const float*)d_in[1]; a.norm_g = (const float*)d_in[2]; a.w_in = (const float*)d_in[3];
    a.qn_g = (const float*)d_in[4]; a.kn_g = (const float*)d_in[5]; a.pool_w = (const float*)d_in[6]; a.pool_b = (const float*)d_in[7];
    a.pool_s = (const float*)d_in[8]; a.w_a = (const float*)d_in[9]; a.w_b = (const float*)d_in[10]; a.w_out = (const float*)d_in[11];
    a.out = (float*)d_out; a.ws = (unsigned char*)d_ws;
#if PER_PHASE_LAUNCH
    for (int ph = 0; ph < N_PHASES; ++ph) {
        a.ph_lo = ph; a.ph_hi = ph + 1;
        hipLaunchKernelGGL(mega_fwd, dim3(grid), dim3(512), LDS_BYTES, stream, a);
    }
#else
    a.ph_lo = 0; a.ph_hi = N_PHASES;
    void* args[] = {&a};
    hipError_t e = hipLaunchCooperativeKernel((const void*)mega_fwd, dim3(grid), dim3(512), args, LDS_BYTES, stream);
    if (e != hipSuccess) fprintf(stderr, "cooperative launch failed: %s (grid %d)\n", hipGetErrorString(e), grid);
#endif
}
```
